# Optimizing an MI355X kernel written in HIP

```python
import math
import jax, jax.numpy as jnp
from jax import lax
import numpy as np

D_MODEL = 1024
BATCH = 8
SEQ = 4096
DEPTH = 2

HEAD_DIM = 64
A_HEADS = 4
A_WIDTH = A_HEADS * HEAD_DIM
A_PATTERNS = ((128, 1), (512, 4), (2048, 16))
B_HEADS = 6
B_KV_HEADS = 2
B_GROUP = B_HEADS // B_KV_HEADS
B_WIDTH = B_HEADS * HEAD_DIM
B_KV_WIDTH = B_KV_HEADS * HEAD_DIM
B_WINDOW = 128
B_BLOCK = 128
C_HEADS = 6
C_NOPE = 64
C_ROPE = 32
C_V = 64
C_WIDTH = C_HEADS * C_V
Q_LORA = 256
KV_LORA = 128
ROPE_THETA = 10000.0
C_QBLOCK = 128
D_MIX = A_WIDTH + B_WIDTH + C_WIDTH
IN_SPLITS = (A_WIDTH, A_WIDTH, A_WIDTH, A_WIDTH,
             B_WIDTH, B_KV_WIDTH, B_KV_WIDTH, B_WIDTH,
             Q_LORA, KV_LORA, C_ROPE, C_WIDTH)
D_IN = 4 * A_WIDTH + 2 * B_WIDTH + 2 * B_KV_WIDTH + Q_LORA + KV_LORA + C_ROPE + C_WIDTH
N_ALIBI = A_HEADS + B_HEADS
RMS_EPS = 1e-6
NEG_INF = -1e30

kernel_name = "hybrid_dilated_swa_mla_encoder"


def rmsnorm(x, g):
    xf = x.astype(jnp.float32)
    y = xf * lax.rsqrt(jnp.mean(xf * xf, axis=-1, keepdims=True) + RMS_EPS)
    return (y * g.astype(jnp.float32)).astype(x.dtype)


def split_cols(t, sizes):
    out, off = [], 0
    for s in sizes:
        out.append(t[..., off:off + s])
        off += s
    return out


def alibi_slopes():
    s = 2.0 ** (-8.0 * jnp.arange(1, N_ALIBI + 1, dtype=jnp.float32) / N_ALIBI)
    return s[B_HEADS:], s[:B_HEADS]


def rope(t, positions):
    half = C_ROPE // 2
    freq = ROPE_THETA ** (-2.0 * jnp.arange(half, dtype=jnp.float32) / C_ROPE)
    ang = positions.astype(jnp.float32)[..., None] * freq
    ang = ang.reshape(ang.shape[:2] + (1,) * (t.ndim - 3) + (half,))
    cos, sin = jnp.cos(ang), jnp.sin(ang)
    tf = t.astype(jnp.float32)
    t1, t2 = tf[..., :half], tf[..., half:]
    return jnp.concatenate([t1 * cos - t2 * sin, t1 * sin + t2 * cos], axis=-1).astype(t.dtype)


def _windows(t, blk, nb):
    return t


def banded_attention(q, k, v, half, blk, key_valid, dist_scale, slopes):
    *lead, hk, g, L, dh = q.shape
    nb = L // blk
    pad_kv = [(0, 0)] * (k.ndim - 2) + [(blk, blk), (0, 0)]
    kp = jnp.pad(k, pad_kv).reshape(k.shape[:-2] + (nb + 2, blk, dh))
    vp = jnp.pad(v, pad_kv).reshape(v.shape[:-2] + (nb + 2, blk, dh))
    kw = jnp.concatenate([kp[..., :-2, :, :], kp[..., 1:-1, :, :], kp[..., 2:, :, :]], axis=-2)
    vw = jnp.concatenate([vp[..., :-2, :, :], vp[..., 1:-1, :, :], vp[..., 2:, :, :]], axis=-2)
    valp = jnp.pad(key_valid, [(0, 0)] * (key_valid.ndim - 1) + [(blk, blk)], constant_values=False)
    valp = valp.reshape(key_valid.shape[:-1] + (nb + 2, blk))
    valw = jnp.concatenate([valp[..., :-2, :], valp[..., 1:-1, :], valp[..., 2:, :]], axis=-1)
    rel = jnp.arange(3 * blk)[None, :] - blk - jnp.arange(blk)[:, None]
    band = jnp.abs(rel) <= half
    bias = -slopes.astype(jnp.float32)[:, :, None, None, None] * (jnp.abs(rel) * dist_scale).astype(jnp.float32)
    qb = q.reshape(tuple(lead) + (hk, g, nb, blk, dh))
    s = jnp.einsum('...hgnqd,...hnkd->...hgnqk', qb, kw).astype(jnp.float32) * (dh ** -0.5) + bias
    mask = band & valw[..., None, None, :, None, :]
    s = jnp.where(mask, s, NEG_INF)
    m = jnp.max(s, axis=-1)
    p = jnp.exp(s - m[..., None])
    l = jnp.sum(p, axis=-1)
    acc = jnp.einsum('...hgnqk,...hnkd->...hgnqd', p, vw.astype(jnp.float32))
    shp = tuple(lead) + (hk, g, L)
    return m.reshape(shp), l.reshape(shp), acc.reshape(shp + (dh,))


def dilated_mixture(q, k, v, slopes_a):
    B, S, H, dh = q.shape
    ms, ls, accs = [], [], []
    for window, d in A_PATTERNS:
        half = window // (2 * d)
        blk = half
        chunk = d * blk
        Sp = ((S + chunk - 1) // chunk) * chunk
        L = Sp // d

        def to_res(t):
            t = jnp.pad(t, [(0, 0), (0, Sp - S), (0, 0), (0, 0)])
            return t.reshape(B, L, d, H, dh).transpose(0, 2, 3, 1, 4)

        qr, kr, vr = to_res(q)[:, :, :, None], to_res(k), to_res(v)
        valid = (jnp.arange(L)[None, :] * d + jnp.arange(d)[:, None]) < S
        m, l, acc = banded_attention(qr, kr, vr, half, blk, valid, d, slopes_a[:, None])
        ms.append(m[:, :, :, 0].transpose(0, 3, 1, 2).reshape(B, Sp, H)[:, :S])
        ls.append(l[:, :, :, 0].transpose(0, 3, 1, 2).reshape(B, Sp, H)[:, :S])
        accs.append(acc[:, :, :, 0].transpose(0, 3, 1, 2, 4).reshape(B, Sp, H, dh)[:, :S])
    M = jnp.maximum(jnp.maximum(ms[0], ms[1]), ms[2])
    es = [jnp.exp(m - M) for m in ms]
    num = es[0][..., None] * accs[0] + es[1][..., None] * accs[1] + es[2][..., None] * accs[2]
    den = es[0] * ls[0] + es[1] * ls[1] + es[2] * ls[2]
    out = num / den[..., None]
    return out.reshape(B, S, H * dh).astype(q.dtype)


def windowed_gqa_sink(q, k, v, sink, slopes_b):
    B, S, _, dh = q.shape
    qg = q.reshape(B, S, B_KV_HEADS, B_GROUP, dh).transpose(0, 2, 3, 1, 4)
    kg = k.transpose(0, 2, 1, 3)
    vg = v.transpose(0, 2, 1, 3)
    valid = jnp.ones((S,), dtype=bool)
    m, l, acc = banded_attention(qg, kg, vg, B_WINDOW, B_BLOCK, valid, 1,
                                 slopes_b.reshape(B_KV_HEADS, B_GROUP))
    sk = sink.astype(jnp.float32).reshape(B_KV_HEADS, B_GROUP)[:, :, None]
    M = jnp.maximum(m, sk)
    e = jnp.exp(m - M)
    den = l * e + jnp.exp(sk - M)
    out = acc * (e / den)[..., None]
    return out.transpose(0, 3, 1, 2, 4).reshape(B, S, B_WIDTH).astype(q.dtype)


def mla(cq, ckv, kr, positions, q_norm_g, kv_norm_g, w_uq, w_ukv):
    B, S, _ = cq.shape
    q = (rmsnorm(cq, q_norm_g) @ w_uq).reshape(B, S, C_HEADS, C_NOPE + C_ROPE)
    q_nope = q[..., :C_NOPE]
    q_rope = rope(q[..., C_NOPE:], positions)
    kv = (rmsnorm(ckv, kv_norm_g) @ w_ukv).reshape(B, S, C_HEADS, C_NOPE + C_V)
    k_nope = kv[..., :C_NOPE]
    v32 = kv[..., C_NOPE:].astype(jnp.float32)
    k_rope = rope(kr, positions)
    nq = S // C_QBLOCK
    qn = q_nope.reshape(B, nq, C_QBLOCK, C_HEADS, C_NOPE).swapaxes(0, 1)
    qr = q_rope.reshape(B, nq, C_QBLOCK, C_HEADS, C_ROPE).swapaxes(0, 1)
    scale = (C_NOPE + C_ROPE) ** -0.5

    def block(args):
        qn_b, qr_b = args
        s = (jnp.einsum('bqhd,bkhd->bhqk', qn_b, k_nope)
             + jnp.einsum('bqhd,bkd->bhqk', qr_b, k_rope)).astype(jnp.float32) * scale
        p = jax.nn.softmax(s, axis=-1)
        return jnp.einsum('bhqk,bkhd->bqhd', p, v32)

    o = lax.map(block, (qn, qr))
    return o.swapaxes(0, 1).reshape(B, S, C_WIDTH).astype(cq.dtype)


def setup_inputs(seed: int = 0) -> dict:
    key = jax.random.key(seed)
    ks = jax.random.split(key, 13)
    f32 = jnp.float32
    x = jax.random.normal(ks[0], (BATCH, SEQ, D_MODEL), f32)
    offset = jax.random.randint(ks[1], (BATCH, 1), 0, 1024, dtype=jnp.int32)
    positions = (offset + jnp.arange(SEQ, dtype=jnp.int32)[None, :]).astype(jnp.int32)
    pre_norm = 1.0 + 0.02 * jax.random.normal(ks[2], (DEPTH, D_MODEL), f32)
    w_in = jax.random.normal(ks[3], (DEPTH, D_MODEL, D_IN), f32) * D_MODEL ** -0.5
    q_a_norm = 1.0 + 0.02 * jax.random.normal(ks[4], (DEPTH, Q_LORA), f32)
    kv_a_norm = 1.0 + 0.02 * jax.random.normal(ks[5], (DEPTH, KV_LORA), f32)
    w_uq = jax.random.normal(ks[6], (DEPTH, Q_LORA, C_HEADS * (C_NOPE + C_ROPE)), f32) * Q_LORA ** -0.5
    w_ukv = jax.random.normal(ks[7], (DEPTH, KV_LORA, C_HEADS * (C_NOPE + C_V)), f32) * KV_LORA ** -0.5
    sink = 0.5 * jax.random.normal(ks[8], (DEPTH, B_HEADS), f32)
    w_o = jax.random.normal(ks[9], (DEPTH, D_MIX, D_MODEL), f32) * D_MIX ** -0.5
    post_norm = 1.0 + 0.02 * jax.random.normal(ks[10], (DEPTH, D_MODEL), f32)
    return {"x": x, "positions": positions, "pre_norm": pre_norm, "w_in": w_in,
            "q_a_norm": q_a_norm, "kv_a_norm": kv_a_norm, "w_uq": w_uq, "w_ukv": w_ukv,
            "sink": sink, "w_o": w_o, "post_norm": post_norm}


def reference(x, positions, pre_norm, w_in, q_a_norm, kv_a_norm, w_uq, w_ukv, sink, w_o, post_norm):
    B, S, _ = x.shape
    slopes_a, slopes_b = alibi_slopes()
    for i in range(DEPTH):
        h = rmsnorm(x, pre_norm[i])
        proj = h @ w_in[i]
        (qa, ka, va, ga, qb, kb, vb, gb, cq, ckv, kr, gc) = split_cols(proj, IN_SPLITS)
        ya = dilated_mixture(qa.reshape(B, S, A_HEADS, HEAD_DIM), ka.reshape(B, S, A_HEADS, HEAD_DIM),
                             va.reshape(B, S, A_HEADS, HEAD_DIM), slopes_a) * jax.nn.silu(ga)
        yb = windowed_gqa_sink(qb.reshape(B, S, B_HEADS, HEAD_DIM), kb.reshape(B, S, B_KV_HEADS, HEAD_DIM),
                               vb.reshape(B, S, B_KV_HEADS, HEAD_DIM), sink[i], slopes_b) * jax.nn.silu(gb)
        yc = mla(cq, ckv, kr, positions, q_a_norm[i], kv_a_norm[i], w_uq[i], w_ukv[i]) * jax.nn.silu(gc)
        y = jnp.concatenate([ya, yb, yc], axis=-1) @ w_o[i]
        x = x + rmsnorm(y, post_norm[i])
    return x
```

```cpp
#include <hip/hip_runtime.h>
#include <hip/hip_cooperative_groups.h>
#include <cstdint>
#include <cstdio>
#define WGM_GEMM1 4
#define WGM_OUT 4

constexpr int NBATCH = 8, SEQ = 4096, T = NBATCH * SEQ, DM = 1024, DIN = 2848, NP = 3072, DEPTH = 2;
constexpr int C_QA = 0, C_KA = 256, C_VA = 512, C_GA = 768, C_QB = 1024, C_KB = 1408, C_VB = 1536, C_GB = 1664,
              C_CQ = 2048, C_CKV = 2304, C_KR = 2432, C_GC = 2464;
constexpr int QC_LD = 576, KC_LD = 576, VC_LD = 384;
constexpr float LOG2E = 1.4426950408889634f;
constexpr float QS_AB = 0.125f * LOG2E;
constexpr float QS_C = 0.10206207261596575f * LOG2E;
constexpr float RMS_EPS = 1e-6f;

typedef unsigned short bf16_t;
typedef float f32x4 __attribute__((ext_vector_type(4)));
typedef unsigned u32x4 __attribute__((ext_vector_type(4)));
typedef unsigned u32x2 __attribute__((ext_vector_type(2)));

__device__ __forceinline__ int tid_opaque() { int t = threadIdx.x; asm volatile("" : "+v"(t)); return t; }
__device__ __forceinline__ float bf2f(bf16_t b) { return __uint_as_float((unsigned)b << 16); }
typedef float f32x2_t __attribute__((ext_vector_type(2))); typedef __bf16 bf16x2_t __attribute__((ext_vector_type(2)));
__device__ __forceinline__ unsigned pk2(float lo, float hi) { const f32x2_t v = {lo, hi}; const bf16x2_t b = __builtin_convertvector(v, bf16x2_t); return __builtin_bit_cast(unsigned, b); }
__device__ __forceinline__ unsigned f2bf(float f) { return pk2(f, 0.f) & 0xffffu; }
__device__ __forceinline__ float silu_f(float g) { return g * __builtin_amdgcn_rcpf(1.f + __builtin_amdgcn_exp2f(-g * LOG2E)); }
__device__ __forceinline__ int rope_perm(int r) { return r < 16 ? 2 * r : 2 * (r - 16) + 1; }
__device__ __forceinline__ float slope_all(int i) { return __builtin_amdgcn_exp2f(-0.8f * (float)(i + 1)); }

constexpr size_t MiB = 1u << 20;
constexpr size_t WS_CTL = 0;
constexpr size_t WS_WIN = 2 * MiB;
constexpr size_t WS_WUQ = 14 * MiB;
constexpr size_t WS_WUKV = 15 * MiB;
constexpr size_t WS_WO = 16 * MiB;
constexpr size_t WS_CS = 20 * MiB;
constexpr size_t WS_PARTQ = 24 * MiB;
constexpr size_t WS_PARTKV = 25 * MiB;
constexpr size_t WS_LSE1 = 26 * MiB;
constexpr size_t WS_LSE2 = 27 * MiB;
constexpr size_t WS_RINV = 28 * MiB;
constexpr size_t WS_XB = 32 * MiB;
constexpr size_t WS_PROJ = 96 * MiB;
constexpr size_t WS_QC = 288 * MiB;
constexpr size_t WS_KC = 324 * MiB;
constexpr size_t WS_VC = 360 * MiB;
constexpr size_t WS_OA1 = 384 * MiB;
constexpr size_t WS_OA2 = 400 * MiB;
constexpr size_t WS_YMIX = 416 * MiB;
constexpr size_t WS_Y = 96 * MiB;
constexpr size_t WS_END = 480 * MiB;

struct Params {
    const float* x; const int* pos; const float* pre_norm; const float* w_in; const float* q_norm; const float* kv_norm;
    const float* w_uq; const float* w_ukv; const float* sink; const float* w_o; const float* post_norm;
    float* out; unsigned char* ws;
};

template <int KIND, int NTH>
__device__ __forceinline__ void prep_tile(const float* W, const float* g, bf16_t* WT, int K, int N, int ldk, int tile, float* lds) {
    const int tid = threadIdx.x, ntn = (N + 63) / 64, kt = tile / ntn, nt = tile % ntn, k0 = kt * 64, n0 = nt * 64;
    constexpr int RPI = NTH / 64;
    for (int i = 0; i < 64 / RPI; ++i) { const int kk = i * RPI + (tid >> 6), nn = tid & 63, n = n0 + nn;
        float v = 0.f; if (n < N) v = W[(size_t)(k0 + kk) * N + n] * (g ? g[k0 + kk] : 1.f);
        lds[kk * 65 + nn] = v; }
    __syncthreads();
    for (int i = 0; i < 64 / RPI; ++i) { const int nn = i * RPI + (tid >> 6), kk = tid & 63, n = n0 + nn;
        if (n < N) { int dst = n; float sc = 1.f;
            if (KIND == 0) { if (n < 256 || (n >= C_QB && n < C_KB)) sc = QS_AB; if (n >= C_KR && n < C_GC) dst = C_KR + rope_perm(n - C_KR); }
            if (KIND == 1) { sc = QS_C; const int h = n / 96, w = n % 96; dst = h * 96 + (w < 64 ? w : 64 + rope_perm(w - 64)); }
            if (KIND == 2) { const int h = n / 128, w = n % 128; dst = (w < 64) ? h * 64 + w : 384 + h * 64 + (w - 64); }
            WT[(size_t)dst * ldk + k0 + kk] = (bf16_t)f2bf(lds[kk * 65 + nn] * sc); } }
    __syncthreads();
}
constexpr int TL_IN = 16 * 45, TL_UQ = 4 * 9, TL_UKV = 2 * 12, TL_O = 16 * 16, TL_LAYER = TL_IN + TL_UQ + TL_UKV + TL_O;
template <int NTH>
__device__ __forceinline__ void prologue_weights(const Params& p, float* lds, int bid, int nblk) {
    for (int it = bid; it < DEPTH * TL_LAYER; it += nblk) {
        const int l = it / TL_LAYER; int r = it % TL_LAYER;
        bf16_t* win = (bf16_t*)(p.ws + WS_WIN) + (size_t)l * NP * DM; bf16_t* wuq = (bf16_t*)(p.ws + WS_WUQ) + (size_t)l * 768 * 256;
        bf16_t* wukv = (bf16_t*)(p.ws + WS_WUKV) + (size_t)l * 768 * 256; bf16_t* wo = (bf16_t*)(p.ws + WS_WO) + (size_t)l * DM * DM;
        if (r < TL_IN) { prep_tile<0, NTH>(p.w_in + (size_t)l * DM * DIN, p.pre_norm + l * DM, win, DM, DIN, DM, r, lds); continue; } r -= TL_IN;
        if (r < TL_UQ) { prep_tile<1, NTH>(p.w_uq + (size_t)l * 256 * 576, p.q_norm + l * 256, wuq, 256, 576, 256, r, lds); continue; } r -= TL_UQ;
        if (r < TL_UKV) { prep_tile<2, NTH>(p.w_ukv + (size_t)l * 128 * 768, p.kv_norm + l * 128, wukv, 128, 768, 256, r, lds); continue; } r -= TL_UKV;
        prep_tile<3, NTH>(p.w_o + (size_t)l * DM * DM, nullptr, wo, DM, DM, DM, r, lds);
    }
    const int gt = bid * NTH + threadIdx.x, ng = nblk * NTH;
    for (int l = 0; l < DEPTH; ++l) {
        unsigned* a = (unsigned*)((bf16_t*)(p.ws + WS_WIN) + (size_t)l * NP * DM + (size_t)DIN * DM);
        for (int i = gt; i < (NP - DIN) * DM / 2; i += ng) a[i] = 0u;
        unsigned* b = (unsigned*)((bf16_t*)(p.ws + WS_WUQ) + (size_t)l * 768 * 256 + (size_t)576 * 256);
        for (int i = gt; i < 192 * 256 / 2; i += ng) b[i] = 0u;
        unsigned* c = (unsigned*)((bf16_t*)(p.ws + WS_WUKV) + (size_t)l * 768 * 256);
        for (int i = gt; i < 768 * 64; i += ng) { const int row = i / 64, cw = i % 64; c[row * 128 + 64 + cw] = 0u; }
    }
}
__device__ __forceinline__ void prologue_rope(const Params& p, int gt, int ng) {
    float2* cs = (float2*)(p.ws + WS_CS);
    for (int i = gt; i < T * 16; i += ng) { const int t = i >> 4, f = i & 15;
        const float freq = __builtin_amdgcn_exp2f(-(float)f * (13.287712379549449f / 16.f));
        const float ang = (float)p.pos[t] * freq;
        double rev = (double)ang * 0.15915494309189535; rev -= __builtin_rint(rev);
        const float rv = (float)rev;
        cs[i] = make_float2(__builtin_amdgcn_cosf(rv), __builtin_amdgcn_sinf(rv)); }
}
__device__ __forceinline__ float wave_sum(float v) {
#pragma unroll
    for (int o = 1; o < 64; o <<= 1) v += __shfl_xor(v, o);
    return v;
}
template <int MODE>
__device__ __forceinline__ void row_pass(const float* x, const bf16_t* xbin, const bf16_t* y, const float* g, float* out, bf16_t* xb, float* rinv, int gw, int ngw, int lane) {
    constexpr int R = 2;
    for (int m0 = gw; m0 < T; m0 += R * ngw) {
        f32x4 v[R][4], w[R][4]; float ri[R];
#pragma unroll
        for (int rr = 0; rr < R; ++rr) { const int m = m0 + rr * ngw; if (m < T) {
            if (MODE >= 1) { const u32x2* xr = (const u32x2*)(xbin + (size_t)m * DM) + lane; ri[rr] = rinv[m];
#pragma unroll
                for (int j = 0; j < 4; ++j) { const u32x2 xx = xr[64 * j]; v[rr][j] = (f32x4){__uint_as_float(xx.x << 16), __uint_as_float(xx.x & 0xffff0000u), __uint_as_float(xx.y << 16), __uint_as_float(xx.y & 0xffff0000u)}; } }
            else { const f32x4* xr = (const f32x4*)(x + (size_t)m * DM) + lane;
#pragma unroll
                for (int j = 0; j < 4; ++j) v[rr][j] = xr[64 * j]; }
            if (MODE >= 1) { const u32x2* yr = (const u32x2*)(y + (size_t)m * DM) + lane;
#pragma unroll
                for (int j = 0; j < 4; ++j) { const u32x2 yy = yr[64 * j]; w[rr][j] = (f32x4){__uint_as_float(yy.x << 16), __uint_as_float(yy.x & 0xffff0000u), __uint_as_float(yy.y << 16), __uint_as_float(yy.y & 0xffff0000u)}; } } } }
#pragma unroll
        for (int rr = 0; rr < R; ++rr) { const int m = m0 + rr * ngw; if (m < T) {
            if (MODE >= 1) {
#pragma unroll
                for (int j = 0; j < 4; ++j) v[rr][j] = v[rr][j] * ri[rr]; }
            if (MODE >= 1) { float s = 0.f;
#pragma unroll
                for (int j = 0; j < 4; ++j) s += (w[rr][j].x * w[rr][j].x + w[rr][j].y * w[rr][j].y) + (w[rr][j].z * w[rr][j].z + w[rr][j].w * w[rr][j].w);
                const float rs = 1.f / sqrtf(wave_sum(s) * (1.f / DM) + RMS_EPS);
#pragma unroll
                for (int j = 0; j < 4; ++j) { const f32x4 gg = ((const f32x4*)g)[lane + 64 * j]; v[rr][j] = v[rr][j] + w[rr][j] * rs * gg; if (MODE == 2) ((f32x4*)(out + (size_t)m * DM))[lane + 64 * j] = v[rr][j]; } }
            if (MODE <= 1) { float s = 0.f;
#pragma unroll
                for (int j = 0; j < 4; ++j) s += (v[rr][j].x * v[rr][j].x + v[rr][j].y * v[rr][j].y) + (v[rr][j].z * v[rr][j].z + v[rr][j].w * v[rr][j].w);
                const float ms = sqrtf(wave_sum(s) * (1.f / DM) + RMS_EPS), rs = 1.f / ms;
                if (lane == 0) rinv[m] = ms;
                u32x2* o8 = (u32x2*)(xb + (size_t)m * DM) + lane;
#pragma unroll
                for (int j = 0; j < 4; ++j) { u32x2 o; o.x = pk2(v[rr][j].x * rs, v[rr][j].y * rs); o.y = pk2(v[rr][j].z * rs, v[rr][j].w * rs); o8[64 * j] = o; } } } }
    }
}
__device__ __forceinline__ void kr_rope_pass(const Params& p, int gt, int ng) {
    const bf16_t* proj = (const bf16_t*)(p.ws + WS_PROJ); bf16_t* kc = (bf16_t*)(p.ws + WS_KC); const float2* cs = (const float2*)(p.ws + WS_CS);
    for (int i = gt; i < T * 16; i += ng) { const int t = i >> 4, f = i & 15;
        const unsigned w = *(const unsigned*)(proj + (size_t)t * NP + C_KR + 2 * f);
        const float t1 = bf2f((bf16_t)(w & 0xffffu)), t2 = bf2f((bf16_t)(w >> 16)); const float2 c = cs[i];
        const unsigned o = pk2(t1 * c.x - t2 * c.y, t1 * c.y + t2 * c.x);
#pragma unroll
        for (int h = 0; h < 6; ++h) *(unsigned*)(kc + (size_t)t * KC_LD + h * 96 + 64 + 2 * f) = o; }
}

struct EpProj { bf16_t* O;
    __device__ __forceinline__ void apply8(int row, int col, const float* v) const {
        if (col >= DIN) return;
        u32x4 w; w.x = pk2(v[0], v[1]); w.y = pk2(v[2], v[3]); w.z = pk2(v[4], v[5]); w.w = pk2(v[6], v[7]); *(u32x4*)(O + (size_t)row * NP + col) = w; } };
struct EpQ { bf16_t* O; const float* part;
    __device__ __forceinline__ float rowscale(int row) const { const f32x4 pp = *(const f32x4*)(part + (size_t)row * 4); return 1.f / sqrtf(((pp.x + pp.y) + (pp.z + pp.w)) * (1.f / 256.f) + RMS_EPS); }
    __device__ __forceinline__ void apply8s(int row, int col, const float* v, float rs) const {
        if (col >= 576) return;
        u32x4 w; w.x = pk2(v[0] * rs, v[1] * rs); w.y = pk2(v[2] * rs, v[3] * rs); w.z = pk2(v[4] * rs, v[5] * rs); w.w = pk2(v[6] * rs, v[7] * rs); *(u32x4*)(O + (size_t)row * QC_LD + col) = w; } };
struct EpKV { bf16_t* Kc; bf16_t* Vc; const float* part;
    __device__ __forceinline__ float rowscale(int row) const { const f32x4 pp = *(const f32x4*)(part + (size_t)row * 4); return 1.f / sqrtf(((pp.x + pp.y) + (pp.z + pp.w)) * (1.f / 128.f) + RMS_EPS); }
    __device__ __forceinline__ void apply8s(int row, int col, const float* v, float rs) const {
        u32x4 w; w.x = pk2(v[0] * rs, v[1] * rs); w.y = pk2(v[2] * rs, v[3] * rs); w.z = pk2(v[4] * rs, v[5] * rs); w.w = pk2(v[6] * rs, v[7] * rs);
        if (col < 384) { const int h = col >> 6; *(u32x4*)(Kc + (size_t)row * KC_LD + h * 96 + (col & 63)) = w; }
        else *(u32x4*)(Vc + (size_t)row * VC_LD + (col - 384)) = w; } };
struct EpY { bf16_t* O;
    __device__ __forceinline__ void apply8(int row, int col, const float* v) const {
        u32x4 w; w.x = pk2(v[0], v[1]); w.y = pk2(v[2], v[3]); w.z = pk2(v[4], v[5]); w.w = pk2(v[6], v[7]); *(u32x4*)(O + (size_t)row * DM + col) = w; } };
struct EpF32 { float* O;
    __device__ __forceinline__ void apply8(int row, int col, const float* v) const {
        f32x4* o = (f32x4*)(O + (size_t)row * DM + col); o[0] = (f32x4){v[0], v[1], v[2], v[3]}; o[1] = (f32x4){v[4], v[5], v[6], v[7]}; } };


namespace pg8 {
#define PG8_LAS __attribute__((address_space(3)))
typedef short bf16x8 __attribute__((ext_vector_type(8)));
constexpr int BM = 256, BK = 64, HALF = 128, HTB = HALF * BK * 2  , STAGE_BYTES = 8 * HTB, NXCD = 8, WGM = 4;
__host__ __device__ __forceinline__ int lds_byte(int r, int c) { const int st = (r >> 4) * 2 + (c >> 5), rr = r & 15, cc = c & 31, ob = rr * 64 + cc * 2; return st * 1024 + (ob ^ (((ob >> 9) & 1) << 5)); }
__host__ __device__ __forceinline__ void stage_rc(int b, int& R, int& C) { const int st = b / 1024, sb = b % 1024, swz = sb ^ (((sb >> 9) & 1) << 5); R = (st >> 1) * 16 + swz / 64; C = (st & 1) * 32 + (swz % 64) / 2; }
__host__ __device__ __forceinline__ int perm32(int rho) { const int n = rho >> 4, i = rho & 15; return 8 * (i >> 2) + 4 * n + (i & 3); }
struct Unit { int pm, pn; };
struct Gemm { const bf16_t* A; const bf16_t* Bt; int lda, ldb, K; };
struct StaticOrder {
    int nM, nN, nwg, G, c, wgm;
    __host__ __device__ void init(int M, int N, int G_, int c_, int wgm_ = WGM) { nM = M / BM; nN = N / BM; nwg = nM * nN; G = G_; c = c_; wgm = wgm_; }
    __host__ __device__ bool next(int i, Unit& u) const {
        const long L = (long)i * G + c; if (L >= nwg) return false;
        int wgid = (int)L; { const int q = nwg / NXCD, r = nwg % NXCD, xcd = wgid % NXCD, off = wgid / NXCD; wgid = (xcd < r ? xcd * (q + 1) : r * (q + 1) + (xcd - r) * q) + off; }
        const int nig = wgm * nN, gid = wgid / nig, fm = gid * wgm, gsz = (nM - fm) < wgm ? (nM - fm) : wgm;
        u.pm = fm + ((wgid % nig) % gsz); u.pn = (wgid % nig) / gsz; return true;
    }
    __device__ __forceinline__ void a_ready(const Unit&) const {}
    __device__ __forceinline__ void done(const Unit&) const {}
};
struct RangeOrder {
    int lo, cnt, nN, G, c, i0;
    __device__ void init(int lo_, int cnt_, int nN_, int G_, int c_) { lo = lo_; cnt = cnt_; nN = nN_; G = G_; c = c_; i0 = (c >= lo) ? 0 : (lo - c + G - 1) / G; }
    __device__ bool next(int i, Unit& u) const { const int Lg = (i0 + i) * G + c - lo; if (Lg >= cnt) return false; u.pm = Lg / nN; u.pn = Lg % nN; return true; }
    __device__ __forceinline__ void a_ready(const Unit&) const {}
    __device__ __forceinline__ void done(const Unit&) const {}
};
template <class E8, bool SSQ, bool ROWSCALE = false> struct EpiWrap {
    static constexpr bool PERM = true, AFTER_DRAIN = false;
    E8 e; float* partq; float* partkv;
    __device__ __forceinline__ void operator()(const f32x4 (&acc)[2][2][4][2], const Unit& u, int wr, int wc, int fr, int fq) const {
        const int row0 = u.pm * BM + wr * 64 + fr, col0 = u.pn * BM + wc * 32 + 8 * fq;
        float rsc[2][4];
        if constexpr (ROWSCALE) {
#pragma unroll
            for (int ai = 0; ai < 2; ++ai)
#pragma unroll
                for (int m = 0; m < 4; ++m) rsc[ai][m] = e.rowscale(row0 + ai * HALF + m * 16); }
#pragma unroll
        for (int ai = 0; ai < 2; ++ai)
#pragma unroll
            for (int m = 0; m < 4; ++m) { const int row = row0 + ai * HALF + m * 16;
#pragma unroll
                for (int bj = 0; bj < 2; ++bj) { const f32x4 a = acc[ai][bj][m][0], b = acc[ai][bj][m][1]; const float v[8] = {a[0], a[1], a[2], a[3], b[0], b[1], b[2], b[3]};
                    if constexpr (ROWSCALE) e.apply8s(row, col0 + bj * HALF, v, rsc[ai][m]); else e.apply8(row, col0 + bj * HALF, v); }
                }
        if (SSQ && (u.pn == C_CQ / 256 || u.pn == C_CKV / 256)) { const bool isq = (u.pn == C_CQ / 256); float* part = isq ? partq : partkv;
#pragma unroll
            for (int ai = 0; ai < 2; ++ai)
#pragma unroll
                for (int m = 0; m < 4; ++m) { float s = 0.f;
#pragma unroll
                    for (int n = 0; n < 2; ++n) { const f32x4 a = acc[ai][0][m][n]; s += (a[0] * a[0] + a[1] * a[1]) + (a[2] * a[2] + a[3] * a[3]); }
                    if (isq) {
#pragma unroll
                        for (int n = 0; n < 2; ++n) { const f32x4 a = acc[ai][1][m][n]; s += (a[0] * a[0] + a[1] * a[1]) + (a[2] * a[2] + a[3] * a[3]); } }
                    s += __shfl_xor(s, 16); s += __shfl_xor(s, 32);
                    if (fq == 0) part[(size_t)(row0 + ai * HALF + m * 16) * 4 + wc] = s; } }
    }
};
template <class Epi, class Sched, bool ALIGN_EPI = false, bool SP2 = false>
__device__ __forceinline__ void gemm_phase(PG8_LAS unsigned char* lds, const Gemm g, const Sched& S, const Epi& E) {
    const int tid = tid_opaque(), wid = __builtin_amdgcn_readfirstlane(tid >> 6), lane = tid & 63, wr = wid >> 2, wc = wid & 3, fr = lane & 15, fq = lane >> 4;
    const int K = g.K, nt = K / BK, lda = g.lda, ldb = g.ldb;
    unsigned voffA[2], voffB[2];
#pragma unroll
    for (int i = 0; i < 2; ++i) { int R, C; stage_rc(tid * 16 + i * 8192, R, C); const int Rb = Epi::PERM ? ((R & ~31) + perm32(R & 31)) : R;
        voffA[i] = (unsigned)(R * lda + C) * 2u; voffB[i] = (unsigned)(Rb * ldb + C) * 2u; }
    const size_t kstep = (size_t)(BK * 2);
    const size_t hsA = (size_t)HALF * lda * 2, hsB = (size_t)HALF * ldb * 2;
    const size_t tsA = 2 * hsA, tsB = 2 * hsB;
    const unsigned ldsw = (unsigned)wid * 1024u;
    const int aoff = lds_byte(wr * 64 + fr, fq * 8), boff = lds_byte(wc * 32 + fr, fq * 8);
#define PG8_SA(b, h) (((b) * 2 + (h)) * HTB)
#define PG8_SB(b, h) ((4 + (b) * 2 + (h)) * HTB)
#define PG8_STAGE(bufoff, gbase, voff) do { _Pragma("unroll") for (int _i = 0; _i < 2; ++_i) \
        __builtin_amdgcn_global_load_lds((const unsigned*)((const char*)(gbase) + (voff)[_i]), (PG8_LAS unsigned*)(lds + (bufoff) + ldsw + _i * 8192), 16, 0, 0); } while (0)
#define PG8_LDA(dst, b, h) do { _Pragma("unroll") for (int m = 0; m < 4; ++m) _Pragma("unroll") for (int k = 0; k < 2; ++k) dst[m][k] = *(const PG8_LAS bf16x8*)(lds + PG8_SA(b, h) + aoff + m * 2048 + k * 1024); } while (0)
#define PG8_LDB(dst, b, h) do { _Pragma("unroll") for (int n = 0; n < 2; ++n) _Pragma("unroll") for (int k = 0; k < 2; ++k) dst[n][k] = *(const PG8_LAS bf16x8*)(lds + PG8_SB(b, h) + boff + n * 2048 + k * 1024); } while (0)
#define PG8_MMA(ai, bj, At, Bt) do { __builtin_amdgcn_s_setprio(1); _Pragma("unroll") for (int m = 0; m < 4; ++m) _Pragma("unroll") for (int n = 0; n < 2; ++n) _Pragma("unroll") for (int k = 0; k < 2; ++k) \
        acc[ai][bj][m][n] = __builtin_amdgcn_mfma_f32_16x16x32_bf16(Bt[n][k], At[m][k], acc[ai][bj][m][n], 0, 0, 0); __builtin_amdgcn_s_setprio(0); } while (0)
#define PG8_WAIT_V(n) asm volatile("s_waitcnt vmcnt(" #n ")" ::: "memory")
#define PG8_WAIT_L(n) asm volatile("s_waitcnt lgkmcnt(" #n ")" ::: "memory")
#define PG8_BAR __builtin_amdgcn_s_barrier()
#define PG8_SCHED __builtin_amdgcn_sched_barrier(0)
    Unit cur, nxt; int ui = 0;
    if (!S.next(0, cur)) return;
    f32x4 acc[2][2][4][2];
#pragma unroll
    for (int a = 0; a < 2; ++a)
#pragma unroll
        for (int b = 0; b < 2; ++b)
#pragma unroll
            for (int m = 0; m < 4; ++m)
#pragma unroll
                for (int n = 0; n < 2; ++n) acc[a][b][m][n] = (f32x4){0.f, 0.f, 0.f, 0.f};
    bf16x8 At[4][2], B0[2][2], B1[2][2];
    const char* cA = (const char*)g.A + (size_t)cur.pm * tsA; const char* cB = (const char*)g.Bt + (size_t)cur.pn * tsB;
    S.a_ready(cur);
    if constexpr (SP2) {
        PG8_STAGE(PG8_SB(0, 0), cB, voffB); PG8_STAGE(PG8_SB(0, 1), cB + hsB, voffB); PG8_STAGE(PG8_SA(0, 0), cA, voffA); PG8_STAGE(PG8_SA(0, 1), cA + hsA, voffA);
        if (wr == 1) PG8_BAR;
        PG8_WAIT_V(2); PG8_BAR;
        PG8_STAGE(PG8_SB(1, 0), cB + kstep, voffB); PG8_STAGE(PG8_SA(1, 0), cA + kstep, voffA); PG8_STAGE(PG8_SB(1, 1), cB + hsB + kstep, voffB);
        PG8_WAIT_V(6); PG8_BAR;
    } else {
        PG8_STAGE(PG8_SB(0, 0), cB, voffB); PG8_STAGE(PG8_SA(0, 0), cA, voffA); PG8_STAGE(PG8_SB(0, 1), cB + hsB, voffB); PG8_STAGE(PG8_SA(0, 1), cA + hsA, voffA);
        if (wr == 1) PG8_BAR;
        PG8_WAIT_V(4); PG8_BAR;
        PG8_STAGE(PG8_SB(1, 0), cB + kstep, voffB); PG8_STAGE(PG8_SA(1, 0), cA + kstep, voffA); PG8_STAGE(PG8_SB(1, 1), cB + hsB + kstep, voffB);
        PG8_WAIT_V(6); PG8_BAR;
    }
    for (;;) {
        const bool has_next = S.next(ui + 1, nxt);
        const char* nA = has_next ? (const char*)g.A + (size_t)nxt.pm * tsA : cA; const char* nB = has_next ? (const char*)g.Bt + (size_t)nxt.pn * tsB : cB;
#pragma unroll 1
        for (int t = 0; t < nt; t += 2) {
            const bool last = (t == nt - 2);
            const char* a1 = cA + (size_t)(t + 1) * kstep;
            const char* a2 = last ? nA : cA + (size_t)(t + 2) * kstep; const char* b2 = last ? nB : cB + (size_t)(t + 2) * kstep;
            const char* a3 = a2 + kstep; const char* b3 = b2 + kstep;
            if (last && has_next) S.a_ready(nxt);
            if constexpr (SP2) {
            PG8_LDB(B0, 0, 0); PG8_LDB(B1, 0, 1); PG8_SCHED; PG8_LDA(At, 0, 0); PG8_STAGE(PG8_SA(1, 1), a1 + hsA, voffA);
            PG8_WAIT_V(8); PG8_WAIT_L(0); PG8_BAR; PG8_MMA(0, 0, At, B0); PG8_MMA(0, 1, At, B1); PG8_BAR; PG8_SCHED;
            PG8_LDA(At, 0, 1); PG8_STAGE(PG8_SB(0, 0), b2, voffB); PG8_STAGE(PG8_SB(0, 1), b2 + hsB, voffB); PG8_STAGE(PG8_SA(0, 0), a2, voffA);
            PG8_WAIT_V(8); PG8_WAIT_L(0); PG8_BAR; PG8_MMA(1, 0, At, B0); PG8_MMA(1, 1, At, B1); PG8_BAR; PG8_SCHED;
            PG8_LDB(B0, 1, 0); PG8_LDB(B1, 1, 1); PG8_SCHED; PG8_LDA(At, 1, 0); PG8_STAGE(PG8_SA(0, 1), a2 + hsA, voffA);
            PG8_WAIT_V(8); PG8_WAIT_L(0); PG8_BAR; PG8_MMA(0, 0, At, B0); PG8_MMA(0, 1, At, B1); PG8_BAR; PG8_SCHED;
            PG8_LDA(At, 1, 1); PG8_STAGE(PG8_SB(1, 0), b3, voffB); PG8_STAGE(PG8_SB(1, 1), b3 + hsB, voffB); PG8_STAGE(PG8_SA(1, 0), a3, voffA);
            PG8_WAIT_V(8); PG8_WAIT_L(0); PG8_BAR; PG8_MMA(1, 0, At, B0); PG8_MMA(1, 1, At, B1); PG8_BAR; PG8_SCHED;
            } else {
            PG8_LDB(B0, 0, 0); PG8_SCHED; PG8_LDA(At, 0, 0); PG8_STAGE(PG8_SA(1, 1), a1 + hsA, voffA);
            PG8_WAIT_L(8); PG8_BAR; PG8_WAIT_L(0); PG8_MMA(0, 0, At, B0); PG8_BAR; PG8_SCHED;
            PG8_LDB(B1, 0, 1); PG8_STAGE(PG8_SB(0, 0), b2, voffB);
            PG8_BAR; PG8_WAIT_L(0); PG8_MMA(0, 1, At, B1); PG8_BAR;
            PG8_LDA(At, 0, 1); PG8_STAGE(PG8_SA(0, 0), a2, voffA);
            PG8_BAR; PG8_WAIT_L(0); PG8_MMA(1, 0, At, B0); PG8_BAR; PG8_SCHED;
            PG8_STAGE(PG8_SB(0, 1), b2 + hsB, voffB);
            PG8_WAIT_V(6); PG8_BAR; PG8_MMA(1, 1, At, B1); PG8_BAR;
            PG8_LDB(B0, 1, 0); PG8_SCHED; PG8_LDA(At, 1, 0); PG8_STAGE(PG8_SA(0, 1), a2 + hsA, voffA);
            PG8_WAIT_L(8); PG8_BAR; PG8_WAIT_L(0); PG8_MMA(0, 0, At, B0); PG8_BAR; PG8_SCHED;
            PG8_LDB(B1, 1, 1); PG8_STAGE(PG8_SB(1, 0), b3, voffB);
            PG8_BAR; PG8_WAIT_L(0); PG8_MMA(0, 1, At, B1); PG8_BAR;
            PG8_LDA(At, 1, 1); PG8_STAGE(PG8_SA(1, 0), a3, voffA);
            PG8_BAR; PG8_WAIT_L(0); PG8_MMA(1, 0, At, B0); PG8_BAR; PG8_SCHED;
            PG8_STAGE(PG8_SB(1, 1), b3 + hsB, voffB);
            PG8_WAIT_V(6); PG8_BAR; PG8_MMA(1, 1, At, B1); PG8_BAR;
            }
        }
        if constexpr (ALIGN_EPI) { if (wr == 0) PG8_BAR; }
        if constexpr (!Epi::AFTER_DRAIN) { E(acc, cur, wr, wc, fr, fq); S.done(cur); }
        if (!has_next) break;
#pragma unroll
        for (int a = 0; a < 2; ++a)
#pragma unroll
            for (int b = 0; b < 2; ++b)
#pragma unroll
                for (int m = 0; m < 4; ++m)
#pragma unroll
                    for (int n = 0; n < 2; ++n) acc[a][b][m][n] = (f32x4){0.f, 0.f, 0.f, 0.f};
        cur = nxt; cA = nA; cB = nB; ++ui;
        if constexpr (ALIGN_EPI) { if (wr == 1) PG8_BAR; }
    }
    PG8_WAIT_V(0);
    if constexpr (!ALIGN_EPI) { if (wr == 0) PG8_BAR; }
    PG8_BAR;
    if constexpr (Epi::AFTER_DRAIN) { E.fused(acc, cur, wr, wc, fr, fq, lds, wid, lane); S.done(cur); }
#undef PG8_SA
#undef PG8_SB
#undef PG8_STAGE
#undef PG8_LDA
#undef PG8_LDB
#undef PG8_MMA
#undef PG8_WAIT_V
#undef PG8_WAIT_L
#undef PG8_BAR
#undef PG8_SCHED
}
}

namespace att {
typedef short bf16x8 __attribute__((ext_vector_type(8)));
typedef short s16x4 __attribute__((ext_vector_type(4)));
typedef float f32x16 __attribute__((ext_vector_type(16)));
#define ALAS __attribute__((address_space(3)))
#define SBAR() __builtin_amdgcn_sched_barrier(0)
constexpr float THR2 = 11.5f;
constexpr int KP64 = 144, KP96 = 208, VTB = 8192;
__device__ __forceinline__ int crow(int r, int hi) { return (r & 3) + 8 * (r >> 2) + 4 * hi; }
__device__ __forceinline__ unsigned cvtpk(float lo, float hi) { unsigned r; asm volatile("v_cvt_pk_bf16_f32 %0, %1, %2" : "=v"(r) : "v"(lo), "v"(hi)); return r; }
__device__ __forceinline__ int v_st(int k, int c) { const int kk = (k & ~0xC) | ((k & 4) << 1) | ((k & 8) >> 1); return ((kk >> 3) * 2 + (c >> 5)) * 512 + ((kk & 7) * 32 + (c & 31)) * 2; }
__device__ __forceinline__ int v_rd_base(int lane) { return ((lane & 3) << 3) | (((lane >> 2) & 3) << 6) | (((lane >> 4) & 1) << 5) | (((lane >> 5) & 1) << 8); }
constexpr int v_rd_off(int d0, int ks, int half) { return d0 * 512 + ks * 2048 + half * 1024; }
typedef short v4i16_t __attribute__((ext_vector_type(4)));
template <int OFF> __device__ __forceinline__ s16x4 tr_read(int vb) {
    return __builtin_bit_cast(s16x4, __builtin_amdgcn_ds_read_tr16_b64_v4i16((ALAS v4i16_t*)(uintptr_t)(unsigned)(vb + OFF))); }
template <int D0> __device__ __forceinline__ void pv_one(f32x16& od, int vb, bf16x8 pa0, bf16x8 pa1, bf16x8 pa2, bf16x8 pa3) {
    const s16x4 l0 = tr_read<v_rd_off(D0, 0, 0)>(vb), h0 = tr_read<v_rd_off(D0, 0, 1)>(vb), l1 = tr_read<v_rd_off(D0, 1, 0)>(vb), h1 = tr_read<v_rd_off(D0, 1, 1)>(vb);
    const s16x4 l2 = tr_read<v_rd_off(D0, 2, 0)>(vb), h2 = tr_read<v_rd_off(D0, 2, 1)>(vb), l3 = tr_read<v_rd_off(D0, 3, 0)>(vb), h3 = tr_read<v_rd_off(D0, 3, 1)>(vb);
#define ATT_PK(L, H) (bf16x8){L[0], L[1], L[2], L[3], H[0], H[1], H[2], H[3]}
    od = __builtin_amdgcn_mfma_f32_32x32x16_bf16(pa0, ATT_PK(l0, h0), od, 0, 0, 0);
    od = __builtin_amdgcn_mfma_f32_32x32x16_bf16(pa1, ATT_PK(l1, h1), od, 0, 0, 0);
    od = __builtin_amdgcn_mfma_f32_32x32x16_bf16(pa2, ATT_PK(l2, h2), od, 0, 0, 0);
    od = __builtin_amdgcn_mfma_f32_32x32x16_bf16(pa3, ATT_PK(l3, h3), od, 0, 0, 0);
#undef ATT_PK
}
__device__ __forceinline__ void pv2(f32x16* o, int vb, bf16x8 pa0, bf16x8 pa1, bf16x8 pa2, bf16x8 pa3) { pv_one<0>(o[0], vb, pa0, pa1, pa2, pa3); pv_one<1>(o[1], vb, pa0, pa1, pa2, pa3); }
template <int NK, int PITCH> __device__ __forceinline__ void qkt(f32x16& p0, f32x16& p1, const ALAS unsigned char* Ks, const bf16x8* qr, int r32, int hi) {
    p0 = f32x16{}; p1 = f32x16{};
#pragma unroll
    for (int d0 = 0; d0 < NK; ++d0) { const int cb = (d0 * 16 + hi * 8) * 2;
        const bf16x8 b0 = *(const ALAS bf16x8*)(Ks + r32 * PITCH + cb);
        const bf16x8 b1 = *(const ALAS bf16x8*)(Ks + (32 + r32) * PITCH + cb);
        p0 = __builtin_amdgcn_mfma_f32_32x32x16_bf16(b0, qr[d0], p0, 0, 0, 0);
        p1 = __builtin_amdgcn_mfma_f32_32x32x16_bf16(b1, qr[d0], p1, 0, 0, 0); }
}
__device__ __forceinline__ void partialSM(f32x16& p0, f32x16& p1, float& m_reg, float& alpha) {
    float pmax = p0[0];
#pragma unroll
    for (int r = 1; r < 16; ++r) pmax = fmaxf(pmax, p0[r]);
#pragma unroll
    for (int r = 0; r < 16; ++r) pmax = fmaxf(pmax, p1[r]);
    { auto rr = __builtin_amdgcn_permlane32_swap(__float_as_uint(pmax), __float_as_uint(pmax), false, false); pmax = fmaxf(__uint_as_float(rr[0]), __uint_as_float(rr[1])); }
    float mn;
    if (__builtin_expect(__all(pmax - m_reg <= THR2), 1)) { mn = m_reg; alpha = 1.f; }
    else { mn = fmaxf(m_reg, pmax); alpha = __builtin_amdgcn_exp2f(m_reg - mn); m_reg = mn; }
#pragma unroll
    for (int r = 0; r < 16; ++r) { p0[r] -= mn; p1[r] -= mn; }
#pragma unroll
    for (int r = 0; r < 16; ++r) p0[r] = __builtin_amdgcn_exp2f(p0[r]);
}
template <int NK, int PITCH> __device__ __forceinline__ void qkt_neg(f32x16& p0, f32x16& p1, const ALAS unsigned char* Ks, const bf16x8* qr, const f32x16& negm, int r32, int hi) {
#pragma unroll
    for (int d0 = 0; d0 < NK; ++d0) { const int cb = (d0 * 16 + hi * 8) * 2;
        const bf16x8 b0 = *(const ALAS bf16x8*)(Ks + r32 * PITCH + cb);
        const bf16x8 b1 = *(const ALAS bf16x8*)(Ks + (32 + r32) * PITCH + cb);
        if (d0 == 0) { p0 = __builtin_amdgcn_mfma_f32_32x32x16_bf16(b0, qr[0], negm, 0, 0, 0); p1 = __builtin_amdgcn_mfma_f32_32x32x16_bf16(b1, qr[0], negm, 0, 0, 0); }
        else { p0 = __builtin_amdgcn_mfma_f32_32x32x16_bf16(b0, qr[d0], p0, 0, 0, 0); p1 = __builtin_amdgcn_mfma_f32_32x32x16_bf16(b1, qr[d0], p1, 0, 0, 0); } }
}
__device__ __forceinline__ float rowmax32(const f32x16& p0, const f32x16& p1) {
    float pmax = p0[0];
#pragma unroll
    for (int r = 1; r < 16; ++r) pmax = fmaxf(pmax, p0[r]);
#pragma unroll
    for (int r = 0; r < 16; ++r) pmax = fmaxf(pmax, p1[r]);
    auto rr = __builtin_amdgcn_permlane32_swap(__float_as_uint(pmax), __float_as_uint(pmax), false, false); return fmaxf(__uint_as_float(rr[0]), __uint_as_float(rr[1]));
}
__device__ __forceinline__ void partialSM_first(f32x16& p0, f32x16& p1, float& m_reg, f32x16& negm, float& alpha) {
    const float pmax = rowmax32(p0, p1); m_reg = pmax; alpha = 0.f;
#pragma unroll
    for (int r = 0; r < 16; ++r) { p0[r] -= pmax; p1[r] -= pmax; negm[r] = -pmax; }
    asm volatile("" : "+v"(negm));
#pragma unroll
    for (int r = 0; r < 16; ++r) p0[r] = __builtin_amdgcn_exp2f(p0[r]);
}
__device__ __forceinline__ void partialSM_rel(f32x16& p0, f32x16& p1, float& m_reg, f32x16& negm, float& alpha) {
    const float pmax = rowmax32(p0, p1);
    if (__builtin_expect(__all(pmax <= THR2), 1)) { alpha = 1.f; }
    else { const float dl = fmaxf(pmax, 0.f); m_reg += dl; alpha = __builtin_amdgcn_exp2f(-dl);
#pragma unroll
        for (int r = 0; r < 16; ++r) { p0[r] -= dl; p1[r] -= dl; negm[r] = -m_reg; }
        asm volatile("" : "+v"(negm)); }
#pragma unroll
    for (int r = 0; r < 16; ++r) p0[r] = __builtin_amdgcn_exp2f(p0[r]);
}
__device__ __forceinline__ void finishSM(f32x16& p0, f32x16& p1, float alpha, float& l_reg, bf16x8& pa0, bf16x8& pa1, bf16x8& pa2, bf16x8& pa3) {
#pragma unroll
    for (int r = 0; r < 16; ++r) p1[r] = __builtin_amdgcn_exp2f(p1[r]);
    float ps = 0.f;
#pragma unroll
    for (int r = 0; r < 16; ++r) ps += p0[r];
#pragma unroll
    for (int r = 0; r < 16; ++r) ps += p1[r];
    { auto rr = __builtin_amdgcn_permlane32_swap(__float_as_uint(ps), __float_as_uint(ps), false, false); ps = __uint_as_float(rr[0]) + __uint_as_float(rr[1]); }
    l_reg = l_reg * alpha + ps;
#define ATT_PK4(P, BASE, OUT) do { unsigned a0 = cvtpk(P[BASE + 0], P[BASE + 1]), a1 = cvtpk(P[BASE + 2], P[BASE + 3]); \
    unsigned b0 = cvtpk(P[BASE + 4], P[BASE + 5]), b1 = cvtpk(P[BASE + 6], P[BASE + 7]); \
    auto r0 = __builtin_amdgcn_permlane32_swap(a0, b0, false, false); auto r1 = __builtin_amdgcn_permlane32_swap(a1, b1, false, false); \
    u32x4 w = {r0[0], r1[0], r0[1], r1[1]}; OUT = __builtin_bit_cast(bf16x8, w); } while (0)
    ATT_PK4(p0, 0, pa0); ATT_PK4(p0, 8, pa1); ATT_PK4(p1, 0, pa2); ATT_PK4(p1, 8, pa3);
#undef ATT_PK4
}
#define ATT_RESC(a, al_l) do { if (__any((a) < 1.f)) { if (hi == 0) (al_l)[r32] = (a); asm volatile("s_waitcnt lgkmcnt(0)" ::: "memory"); \
    _Pragma("unroll") for (int d_ = 0; d_ < 2; ++d_) _Pragma("unroll") for (int r_ = 0; r_ < 16; ++r_) o[d_][r_] *= (al_l)[crow(r_, hi)]; } } while (0)
__device__ __forceinline__ void unpack8(const u32x4 w, float* f) {
#pragma unroll
    for (int j = 0; j < 4; ++j) { f[2 * j] = __uint_as_float(w[j] << 16); f[2 * j + 1] = __uint_as_float(w[j] & 0xffff0000u); }
}
__device__ __forceinline__ u32x4 pack8(const float* f) { u32x4 w; w.x = pk2(f[0], f[1]); w.y = pk2(f[2], f[3]); w.z = pk2(f[4], f[5]); w.w = pk2(f[6], f[7]); return w; }

__device__ __forceinline__ int cv_st(int k, int sc) { return (sc >> 2) * 4096 + k * 64 + (sc & 3) * 16; }
__device__ __forceinline__ int cv_rd_base(int lane) { return ((lane >> 4) & 1) * 32 + (lane & 3) * 8 + (4 * (lane >> 5) + ((lane & 15) >> 2)) * 64; }
__device__ __forceinline__ bf16x8 c_frag_rt(int vb, int d0, int ks) { const s16x4 l = tr_read<0>(vb + d0 * 4096 + ks * 1024), h = tr_read<512>(vb + d0 * 4096 + ks * 1024); return (bf16x8){l[0], l[1], l[2], l[3], h[0], h[1], h[2], h[3]}; }
__device__ __forceinline__ void finishSM_pack(f32x16& p0, f32x16& p1, float alpha, float& l_reg, bf16x8 (&pa)[4]) {
#pragma unroll
    for (int r = 0; r < 16; ++r) p1[r] = __builtin_amdgcn_exp2f(p1[r]);
    float ps = 0.f;
#pragma unroll
    for (int r = 0; r < 16; ++r) ps += p0[r];
#pragma unroll
    for (int r = 0; r < 16; ++r) ps += p1[r];
    { auto rr = __builtin_amdgcn_permlane32_swap(__float_as_uint(ps), __float_as_uint(ps), false, false); ps = __uint_as_float(rr[0]) + __uint_as_float(rr[1]); }
    l_reg = l_reg * alpha + ps;
    { u32x4 w = {cvtpk(p0[0], p0[1]), cvtpk(p0[2], p0[3]), cvtpk(p0[4], p0[5]), cvtpk(p0[6], p0[7])}; pa[0] = __builtin_bit_cast(bf16x8, w); }
    { u32x4 w = {cvtpk(p0[8], p0[9]), cvtpk(p0[10], p0[11]), cvtpk(p0[12], p0[13]), cvtpk(p0[14], p0[15])}; pa[1] = __builtin_bit_cast(bf16x8, w); }
    { u32x4 w = {cvtpk(p1[0], p1[1]), cvtpk(p1[2], p1[3]), cvtpk(p1[4], p1[5]), cvtpk(p1[6], p1[7])}; pa[2] = __builtin_bit_cast(bf16x8, w); }
    { u32x4 w = {cvtpk(p1[8], p1[9]), cvtpk(p1[10], p1[11]), cvtpk(p1[12], p1[13]), cvtpk(p1[14], p1[15])}; pa[3] = __builtin_bit_cast(bf16x8, w); }
}
template <int I> __device__ __forceinline__ bf16x8 c_frag(int vb, const ALAS unsigned char* Kb) {
    if constexpr (I < 8) { constexpr int d0 = I & 1, ks = I >> 1; const s16x4 l = tr_read<d0 * 4096 + ks * 1024>(vb), h = tr_read<d0 * 4096 + ks * 1024 + 512>(vb); return (bf16x8){l[0], l[1], l[2], l[3], h[0], h[1], h[2], h[3]}; }
    else { constexpr int d0 = (I - 8) >> 1, half = (I - 8) & 1; return *(const ALAS bf16x8*)(Kb + half * 32 * KP96 + d0 * 32); }
}
template <int I> struct CMSeg {
    static __device__ __forceinline__ void run(f32x16* o, f32x16& p0, f32x16& p1, bf16x8 (&F)[4], const bf16x8 (&pa)[4], const bf16x8* qr, const f32x16& negm, int vb, const ALAS unsigned char* Kb) {
        if constexpr (I < 8) { o[I & 1] = __builtin_amdgcn_mfma_f32_32x32x16_bf16(pa[I >> 1], F[I & 3], o[I & 1], 0, 0, 0); }
        else { constexpr int d0 = (I - 8) >> 1, half = (I - 8) & 1;
            if constexpr (half == 0) { if constexpr (d0 == 0) p0 = __builtin_amdgcn_mfma_f32_32x32x16_bf16(F[I & 3], qr[0], negm, 0, 0, 0); else p0 = __builtin_amdgcn_mfma_f32_32x32x16_bf16(F[I & 3], qr[d0], p0, 0, 0, 0); }
            else { if constexpr (d0 == 0) p1 = __builtin_amdgcn_mfma_f32_32x32x16_bf16(F[I & 3], qr[0], negm, 0, 0, 0); else p1 = __builtin_amdgcn_mfma_f32_32x32x16_bf16(F[I & 3], qr[d0], p1, 0, 0, 0); } }
        if constexpr (I + 4 < 20) F[I & 3] = c_frag<I + 4>(vb, Kb);
        SBAR();
        if constexpr (I + 1 < 20) CMSeg<I + 1>::run(o, p0, p1, F, pa, qr, negm, vb, Kb);
    }
};
__device__ __forceinline__ void c_mseg(f32x16* o, f32x16& p0, f32x16& p1, const bf16x8 (&pa)[4], const bf16x8* qr, const f32x16& negm, int vb, const ALAS unsigned char* Kb) {
    bf16x8 F[4]; SBAR();
    F[0] = c_frag<0>(vb, Kb); F[1] = c_frag<1>(vb, Kb); F[2] = c_frag<2>(vb, Kb); F[3] = c_frag<3>(vb, Kb); SBAR();
    CMSeg<0>::run(o, p0, p1, F, pa, qr, negm, vb, Kb);
}

constexpr int C2_KB = 128 * KP96, C2_VB = 2 * VTB, C_LDS_K = 0, C_LDS_V = 2 * C2_KB, C_LDS_WS = C_LDS_V + 3 * C2_VB, C_LDS_STG = C_LDS_WS + 8 * 256, C_LDS_END = C_LDS_STG + 8 * 4096;
template <int F> __device__ __forceinline__ bf16x8 c2_frag(int vb, const ALAS unsigned char* Kb) {
    if constexpr (F < 16) { constexpr int sub = F >> 3, f = F & 7, d0 = f & 1, ks = f >> 1; const s16x4 l = tr_read<sub * VTB + d0 * 4096 + ks * 1024>(vb), h = tr_read<sub * VTB + d0 * 4096 + ks * 1024 + 512>(vb);
        return (bf16x8){l[0], l[1], l[2], l[3], h[0], h[1], h[2], h[3]}; }
    else { constexpr int f = F - 16, sub = f / 12, g = f % 12, d0 = g >> 1, half = g & 1; return *(const ALAS bf16x8*)(Kb + (sub * 64 + half * 32) * KP96 + d0 * 32); }
}
template <int I> struct C2MSeg {
    static __device__ __forceinline__ void run(f32x16* o, f32x16 (&p)[4], bf16x8 (&F)[4], const bf16x8 (&pa)[8], const bf16x8* qr, const f32x16& negm, int vb, const ALAS unsigned char* Kb) {
        if constexpr (I < 16) { constexpr int sub = I >> 3, f = I & 7; o[f & 1] = __builtin_amdgcn_mfma_f32_32x32x16_bf16(pa[sub * 4 + (f >> 1)], F[I & 3], o[f & 1], 0, 0, 0); }
        else { constexpr int f = I - 16, sub = f / 12, g = f % 12, d0 = g >> 1, half = g & 1, idx = sub * 2 + half;
            if constexpr (d0 == 0) p[idx] = __builtin_amdgcn_mfma_f32_32x32x16_bf16(F[I & 3], qr[0], negm, 0, 0, 0); else p[idx] = __builtin_amdgcn_mfma_f32_32x32x16_bf16(F[I & 3], qr[d0], p[idx], 0, 0, 0); }
        if constexpr (I + 4 < 40) F[I & 3] = c2_frag<I + 4>(vb, Kb);
        SBAR();
        if constexpr (I + 1 < 40) C2MSeg<I + 1>::run(o, p, F, pa, qr, negm, vb, Kb);
    }
};
__device__ __forceinline__ void c2_mseg(f32x16* o, f32x16 (&p)[4], const bf16x8 (&pa)[8], const bf16x8* qr, const f32x16& negm, int vb, const ALAS unsigned char* Kb) {
    bf16x8 F[4]; SBAR();
    F[0] = c2_frag<0>(vb, Kb); F[1] = c2_frag<1>(vb, Kb); F[2] = c2_frag<2>(vb, Kb); F[3] = c2_frag<3>(vb, Kb); SBAR();
    C2MSeg<0>::run(o, p, F, pa, qr, negm, vb, Kb);
}
__device__ __forceinline__ float rowmax64(const f32x16 (&p)[4]) {
    float pmax = p[0][0];
#pragma unroll
    for (int i = 0; i < 4; ++i)
#pragma unroll
        for (int r = 0; r < 16; ++r) pmax = fmaxf(pmax, p[i][r]);
    auto rr = __builtin_amdgcn_permlane32_swap(__float_as_uint(pmax), __float_as_uint(pmax), false, false); return fmaxf(__uint_as_float(rr[0]), __uint_as_float(rr[1]));
}
__device__ __forceinline__ void partialSM4_first(f32x16 (&p)[4], float& m_reg, f32x16& negm, float& alpha) {
    const float pmax = rowmax64(p); m_reg = pmax; alpha = 0.f;
#pragma unroll
    for (int i = 0; i < 4; ++i)
#pragma unroll
        for (int r = 0; r < 16; ++r) p[i][r] -= pmax;
#pragma unroll
    for (int r = 0; r < 16; ++r) negm[r] = -pmax;
    asm volatile("" : "+v"(negm));
}
__device__ __forceinline__ void partialSM4_rel(f32x16 (&p)[4], float& m_reg, f32x16& negm, float& alpha) {
    const float pmax = rowmax64(p);
    if (__builtin_expect(__all(pmax <= THR2), 1)) { alpha = 1.f; }
    else { const float dl = fmaxf(pmax, 0.f); m_reg += dl; alpha = __builtin_amdgcn_exp2f(-dl);
#pragma unroll
        for (int i = 0; i < 4; ++i)
#pragma unroll
            for (int r = 0; r < 16; ++r) p[i][r] -= dl;
#pragma unroll
        for (int r = 0; r < 16; ++r) negm[r] = -m_reg;
        asm volatile("" : "+v"(negm)); }
}
__device__ __forceinline__ void finishSM4_pack(f32x16 (&p)[4], float alpha, float& l_reg, bf16x8 (&pa)[8]) {
    float ps = 0.f;
#pragma unroll
    for (int i = 0; i < 4; ++i)
#pragma unroll
        for (int r = 0; r < 16; ++r) { p[i][r] = __builtin_amdgcn_exp2f(p[i][r]); ps += p[i][r]; }
    { auto rr = __builtin_amdgcn_permlane32_swap(__float_as_uint(ps), __float_as_uint(ps), false, false); ps = __uint_as_float(rr[0]) + __uint_as_float(rr[1]); }
    l_reg = l_reg * alpha + ps;
#pragma unroll
    for (int i = 0; i < 4; ++i) {
        { u32x4 w = {cvtpk(p[i][0], p[i][1]), cvtpk(p[i][2], p[i][3]), cvtpk(p[i][4], p[i][5]), cvtpk(p[i][6], p[i][7])}; pa[2 * i] = __builtin_bit_cast(bf16x8, w); }
        { u32x4 w = {cvtpk(p[i][8], p[i][9]), cvtpk(p[i][10], p[i][11]), cvtpk(p[i][12], p[i][13]), cvtpk(p[i][14], p[i][15])}; pa[2 * i + 1] = __builtin_bit_cast(bf16x8, w); } }
}
enum { BK_A_PART = 0, BK_A_MERGE = 1, BK_B = 2 };
template <int KIND> __device__ __forceinline__ void band_prefetch(const Params& p, bf16x8 (&sk)[8], bf16x8 (&sv)[8], int tid);
__device__ __forceinline__ void attn_c_run(const Params& p, int u0, int G, ALAS unsigned char* lds, bf16x8 (&bsk)[8], bf16x8 (&bsv)[8]) {
    const int tid = tid_opaque(), wid = __builtin_amdgcn_readfirstlane(tid >> 6), lane = tid & 63, r32 = lane & 31, hi = lane >> 5;
    if (u0 >= 768) return;
    const bf16_t* qc = (const bf16_t*)(p.ws + WS_QC);
    ALAS unsigned char* K_lds = lds + C_LDS_K; ALAS unsigned char* V_lds = lds + C_LDS_V;
    ALAS float* wsf = (ALAS float*)(lds + C_LDS_WS) + wid * 64; ALAS float* li_l = wsf; ALAS float* al_l = wsf + 32;
    ALAS bf16_t* stg = (ALAS bf16_t*)(lds + C_LDS_STG) + wid * 2048;
    const int sr = tid >> 3, sc = tid & 7, sr2 = tid >> 2, sc2 = 8 + (tid & 3);
    const int kdst = sr * KP96 + sc * 16, kdst2 = sr2 * KP96 + sc2 * 16, vdst = cv_st(sr, sc);
    const int vb0 = (int)(uintptr_t)V_lds + cv_rd_base(lane);
    const ALAS unsigned char* Kb0 = K_lds + r32 * KP96 + hi * 16;
    bf16x8 skA, skB, skR, svA, svB, qr[6];
#define C_UNIT_PTRS(U, KS_, KS2_, VS_, QROW_) do { const int b_ = (U) / 96, h_ = ((U) >> 4) % 6, qb_ = (U) & 15; \
        const bf16_t* kc_ = (const bf16_t*)(p.ws + WS_KC) + (size_t)b_ * SEQ * KC_LD + h_ * 96; const bf16_t* vc_ = (const bf16_t*)(p.ws + WS_VC) + (size_t)b_ * SEQ * VC_LD + h_ * 64; \
        KS_ = kc_ + (size_t)sr * KC_LD + sc * 8; KS2_ = kc_ + (size_t)sr2 * KC_LD + sc2 * 8; VS_ = vc_ + (size_t)sr * VC_LD + sc * 8; QROW_ = (size_t)b_ * SEQ + qb_ * 256 + wid * 32; } while (0)
#define C_SLOAD(t) do { skA = *(const bf16x8*)(ksrc + (size_t)(t) * 128 * KC_LD); skB = *(const bf16x8*)(ksrc + ((size_t)(t) * 128 + 64) * KC_LD); skR = *(const bf16x8*)(ksrc2 + (size_t)(t) * 128 * KC_LD); \
        svA = *(const bf16x8*)(vsrc + (size_t)(t) * 128 * VC_LD); svB = *(const bf16x8*)(vsrc + ((size_t)(t) * 128 + 64) * VC_LD); } while (0)
    const bf16_t* ksrc; const bf16_t* ksrc2; const bf16_t* vsrc; size_t qrow0; int u = u0;
    C_UNIT_PTRS(u, ksrc, ksrc2, vsrc, qrow0);
    C_SLOAD(0);
#pragma unroll
    for (int d0 = 0; d0 < 6; ++d0) qr[d0] = *(const bf16x8*)(qc + (qrow0 + r32) * QC_LD + ((u >> 4) % 6) * 96 + d0 * 16 + hi * 8);
  for (;;) {
    const int h = (u >> 4) % 6;
    float m_reg = 0.f, l_reg = 0.f; f32x16 o[2]; o[0] = f32x16{}; o[1] = f32x16{}; f32x16 negm = f32x16{};
    { const float2* cs = (const float2*)(p.ws + WS_CS) + (qrow0 + r32) * 16;
#pragma unroll
      for (int d0 = 4; d0 < 6; ++d0) { float f[8]; unpack8(__builtin_bit_cast(u32x4, qr[d0]), f);
#pragma unroll
          for (int j = 0; j < 4; ++j) { const float2 c = cs[8 * (d0 - 4) + 4 * hi + j]; const float t1 = f[2 * j], t2 = f[2 * j + 1]; f[2 * j] = t1 * c.x - t2 * c.y; f[2 * j + 1] = t1 * c.y + t2 * c.x; }
          qr[d0] = __builtin_bit_cast(bf16x8, pack8(f)); } }
#define C_SWRITE(ks, vs) do { *(ALAS bf16x8*)(K_lds + (ks) * C2_KB + kdst) = skA; *(ALAS bf16x8*)(K_lds + (ks) * C2_KB + 64 * KP96 + kdst) = skB; *(ALAS bf16x8*)(K_lds + (ks) * C2_KB + kdst2) = skR; \
        *(ALAS bf16x8*)(V_lds + (vs) * C2_VB + vdst) = svA; *(ALAS bf16x8*)(V_lds + (vs) * C2_VB + VTB + vdst) = svB; } while (0)
#define C_HBAR() do { SBAR(); asm volatile("s_waitcnt lgkmcnt(0)" ::: "memory"); __builtin_amdgcn_s_barrier(); asm volatile("" ::: "memory"); SBAR(); } while (0)
    f32x16 pp[4]; float alpha; bf16x8 pa[8]; constexpr int NT = SEQ / 128; const bool lag = wid >= 4;
    int v_prev = 2, v_cur = 0, v_next = 1;
#define C_VROT() do { const int t_ = v_prev; v_prev = v_cur; v_cur = v_next; v_next = t_; } while (0)
#define C_STAGE(T, KSN) do { if ((T) + 1 < NT) { C_SWRITE(KSN, v_next); if ((T) + 2 < NT) C_SLOAD((T) + 2); } } while (0)
#define C_STEP(T, KS) do { \
        C_STAGE(T, 1 - (KS)); \
        c2_mseg(o, pp, pa, qr, negm, vb0 + v_prev * C2_VB, Kb0 + (KS) * C2_KB); \
        C_HBAR(); \
        partialSM4_rel(pp, m_reg, negm, alpha); ATT_RESC(alpha, al_l); finishSM4_pack(pp, alpha, l_reg, pa); \
        C_HBAR(); C_VROT(); } while (0)
    C_SWRITE(0, 0); C_SLOAD(1); __syncthreads();
    if (lag) C_HBAR();
    C_STAGE(0, 1);
    { qkt<6, KP96>(pp[0], pp[1], K_lds, qr, r32, hi); qkt<6, KP96>(pp[2], pp[3], K_lds + 64 * KP96, qr, r32, hi); }
    C_HBAR();
    partialSM4_first(pp, m_reg, negm, alpha); finishSM4_pack(pp, alpha, l_reg, pa);
    C_HBAR(); C_VROT();
    for (int t = 1; t + 1 < NT; t += 2) { C_STEP(t, 1); C_STEP(t + 1, 0); }
    const int un = u + G; const bf16_t* nks; const bf16_t* nks2; const bf16_t* nvs; size_t nqrow = 0;
    if (un < 768) { C_UNIT_PTRS(un, nks, nks2, nvs, nqrow);
        skA = *(const bf16x8*)(nks); skB = *(const bf16x8*)(nks + (size_t)64 * KC_LD); skR = *(const bf16x8*)(nks2); svA = *(const bf16x8*)(nvs); svB = *(const bf16x8*)(nvs + (size_t)64 * VC_LD); }
    c2_mseg(o, pp, pa, qr, negm, vb0 + v_prev * C2_VB, Kb0 + C2_KB);
    if (un < 768) {
#pragma unroll
        for (int d0 = 0; d0 < 6; ++d0) qr[d0] = *(const bf16x8*)(qc + (nqrow + r32) * QC_LD + ((un >> 4) % 6) * 96 + d0 * 16 + hi * 8); }
    C_HBAR();
    partialSM4_rel(pp, m_reg, negm, alpha); ATT_RESC(alpha, al_l); finishSM4_pack(pp, alpha, l_reg, pa);
    C_HBAR(); C_VROT();
    u32x4 gpre[4];
    { const bf16_t* projg = (const bf16_t*)(p.ws + WS_PROJ);
#pragma unroll
      for (int i = 0; i < 4; ++i) gpre[i] = *(const u32x4*)(projg + (qrow0 + i * 8 + (lane >> 3)) * NP + C_GC + h * 64 + (lane & 7) * 8); }
    { const int vbl = vb0 + v_prev * C2_VB;
#pragma unroll
      for (int sub = 0; sub < 2; ++sub)
#pragma unroll
        for (int ks = 0; ks < 4; ++ks) { o[0] = __builtin_amdgcn_mfma_f32_32x32x16_bf16(pa[sub * 4 + ks], c_frag_rt(vbl + sub * VTB, 0, ks), o[0], 0, 0, 0); o[1] = __builtin_amdgcn_mfma_f32_32x32x16_bf16(pa[sub * 4 + ks], c_frag_rt(vbl + sub * VTB, 1, ks), o[1], 0, 0, 0); } }
    if (!lag) C_HBAR();
    if (hi == 0) li_l[r32] = l_reg; asm volatile("s_waitcnt lgkmcnt(0)" ::: "memory");
#pragma unroll
    for (int r = 0; r < 16; ++r) { const int orow = crow(r, hi); const float rl = __builtin_amdgcn_rcpf(li_l[orow]);
#pragma unroll
        for (int d0 = 0; d0 < 2; ++d0) stg[orow * 64 + d0 * 32 + r32] = (bf16_t)f2bf(o[d0][r] * rl); }
    asm volatile("s_waitcnt lgkmcnt(0)" ::: "memory");
    const bf16_t* proj = (const bf16_t*)(p.ws + WS_PROJ); bf16_t* ym = (bf16_t*)(p.ws + WS_YMIX);
#pragma unroll
    for (int i = 0; i < 4; ++i) { const int row = i * 8 + (lane >> 3), ch = lane & 7; const size_t tok = qrow0 + row;
        const u32x4 ov = *(const ALAS u32x4*)(stg + row * 64 + ch * 8); const u32x4 gv = gpre[i];
        float of[8], gf[8]; unpack8(ov, of); unpack8(gv, gf);
#pragma unroll
        for (int j = 0; j < 8; ++j) of[j] *= silu_f(gf[j]);
        *(u32x4*)(ym + tok * DM + 640 + h * 64 + ch * 8) = pack8(of); }
    __syncthreads();
    if (un >= 768) break;
    u = un; ksrc = nks; ksrc2 = nks2; vsrc = nvs; qrow0 = nqrow;
  }
#undef C_UNIT_PTRS
#undef C_VROT
#undef C_STAGE
#undef C_STEP
#undef C_HBAR
#undef C_SLOAD
#undef C_SWRITE
}

template <int F> __device__ __forceinline__ bf16x8 bq_frag(const ALAS unsigned char* Kb) { constexpr int d0 = F >> 1, half = F & 1; return *(const ALAS bf16x8*)(Kb + half * 32 * KP64 + d0 * 32); }
template <int F> __device__ __forceinline__ bf16x8 bv_frag(int vb) { constexpr int d0 = F & 1, ks = F >> 1; const s16x4 l = tr_read<v_rd_off(d0, ks, 0)>(vb), h = tr_read<v_rd_off(d0, ks, 1)>(vb); return (bf16x8){l[0], l[1], l[2], l[3], h[0], h[1], h[2], h[3]}; }
template <int I> struct BandQK { static __device__ __forceinline__ void run(f32x16& p0, f32x16& p1, bf16x8 (&F)[4], const bf16x8* qr, const ALAS unsigned char* Kb) {
        constexpr int d0 = I >> 1, half = I & 1;
        if constexpr (half == 0) { if constexpr (d0 == 0) p0 = __builtin_amdgcn_mfma_f32_32x32x16_bf16(F[I & 3], qr[0], f32x16{}, 0, 0, 0); else p0 = __builtin_amdgcn_mfma_f32_32x32x16_bf16(F[I & 3], qr[d0], p0, 0, 0, 0); }
        else { if constexpr (d0 == 0) p1 = __builtin_amdgcn_mfma_f32_32x32x16_bf16(F[I & 3], qr[0], f32x16{}, 0, 0, 0); else p1 = __builtin_amdgcn_mfma_f32_32x32x16_bf16(F[I & 3], qr[d0], p1, 0, 0, 0); }
        if constexpr (I + 4 < 8) F[I & 3] = bq_frag<I + 4>(Kb);
        SBAR();
        if constexpr (I + 1 < 8) BandQK<I + 1>::run(p0, p1, F, qr, Kb); } };
__device__ __forceinline__ void band_qk(f32x16& p0, f32x16& p1, const bf16x8* qr, const ALAS unsigned char* Kb) {
    bf16x8 F[4]; SBAR(); F[0] = bq_frag<0>(Kb); F[1] = bq_frag<1>(Kb); F[2] = bq_frag<2>(Kb); F[3] = bq_frag<3>(Kb); SBAR();
    BandQK<0>::run(p0, p1, F, qr, Kb);
}
template <int I> struct BandPV { static __device__ __forceinline__ void run(f32x16* o, bf16x8 (&F)[4], const bf16x8 (&pa)[4], int vb) {
        o[I & 1] = __builtin_amdgcn_mfma_f32_32x32x16_bf16(pa[I >> 1], F[I & 3], o[I & 1], 0, 0, 0);
        if constexpr (I + 4 < 8) F[I & 3] = bv_frag<I + 4>(vb);
        SBAR();
        if constexpr (I + 1 < 8) BandPV<I + 1>::run(o, F, pa, vb); } };
template <int C> __device__ __forceinline__ float add_const(float a) { float r; asm("v_add_f32_e32 %0, %2, %1" : "=v"(r) : "v"(a), "n"(__builtin_bit_cast(int, (float)C))); return r; }
__device__ __forceinline__ float fma_abs(float a, float b_abs, float c) { float r; asm("v_fma_f32 %0, %1, |%2|, %3" : "=v"(r) : "v"(a), "v"(b_abs), "v"(c)); return r; }
template <int R> __device__ __forceinline__ void band_bias(f32x16& p0, f32x16& p1, float relb, float nsl) {
    constexpr int C = (R & 3) + 8 * (R >> 2);
    p0[R] = fma_abs(nsl, add_const<C>(relb), p0[R]); p1[R] = fma_abs(nsl, add_const<C + 32>(relb), p1[R]);
    if constexpr (R + 1 < 16) band_bias<R + 1>(p0, p1, relb, nsl);
}
template <int R> __device__ __forceinline__ void band_bias_mask(f32x16& p0, f32x16& p1, float relb, float relbm, float hwf, float nsl, float ninf) {
    constexpr int C = (R & 3) + 8 * (R >> 2);
    const float v0 = fma_abs(nsl, add_const<C>(relb), p0[R]), v1 = fma_abs(nsl, add_const<C + 32>(relb), p1[R]);
    p0[R] = (__builtin_fabsf(add_const<C>(relbm)) <= hwf) ? v0 : ninf; p1[R] = (__builtin_fabsf(add_const<C + 32>(relbm)) <= hwf) ? v1 : ninf;
    if constexpr (R + 1 < 16) band_bias_mask<R + 1>(p0, p1, relb, relbm, hwf, nsl, ninf);
}
struct BandU { const bf16_t* q; const bf16_t* k; const bf16_t* v; bf16_t* opart; float* lsepart; size_t rs, tok0; int d, Q0, L, h; float slope2; };
constexpr int BL_KT = 64 * KP64, BL_V = 8 * BL_KT, BL_WS = BL_V + 8 * VTB, BL_STG = BL_WS + 8 * 512, BL_END = BL_STG + 8 * 2048;
__device__ __forceinline__ void band_make_a(const Params& p, int pat, int u, BandU& D) {
    const int d = pat == 0 ? 1 : (pat == 1 ? 4 : 16), b = u >> 6, h = (u >> 4) & 3, w = u & 15, r = w % d, nb = w / d;
    const bf16_t* proj = (const bf16_t*)(p.ws + WS_PROJ) + ((size_t)b * SEQ + r) * NP;
    D.q = proj + C_QA + h * 64; D.k = proj + C_KA + h * 64; D.v = proj + C_VA + h * 64; D.rs = (size_t)d * NP; D.tok0 = (size_t)b * SEQ + r; D.d = d; D.Q0 = 256 * nb; D.L = SEQ / d; D.h = h;
    D.slope2 = slope_all(6 + h) * LOG2E * (float)d;
    D.opart = (bf16_t*)(p.ws + (pat == 0 ? WS_OA1 : WS_OA2)); D.lsepart = (float*)(p.ws + (pat == 0 ? WS_LSE1 : WS_LSE2));
}
__device__ __forceinline__ void band_make_b(const Params& p, int u, BandU& D) {
    const int b = u >> 5, g = (u >> 4) & 1, nb = u & 15;
    const bf16_t* proj = (const bf16_t*)(p.ws + WS_PROJ) + (size_t)b * SEQ * NP;
    D.q = proj + C_QB + g * 192; D.k = proj + C_KB + g * 64; D.v = proj + C_VB + g * 64; D.rs = NP; D.tok0 = (size_t)b * SEQ; D.d = 1; D.Q0 = 256 * nb; D.L = SEQ; D.h = g * 3; D.slope2 = 0.f; D.opart = nullptr; D.lsepart = nullptr;
}
template <int KIND> __device__ __forceinline__ bool band_item(const Params& p, int k, BandU& D) {
    const int G = gridDim.x, bx = blockIdx.x, c = (G % 8 == 0) ? (bx % 8) * (G / 8) + bx / 8 : bx;
    const int nA = c < 512 ? (512 - c + G - 1) / G : 0, nB = c < 256 ? (256 - c + G - 1) / G : 0;
    if (KIND == BK_A_PART) { if (k >= 2 * nA) return false; if (k < nA) band_make_a(p, 0, c + k * G, D); else band_make_a(p, 1, c + (k - nA) * G, D); return true; }
    if (KIND == BK_A_MERGE) { if (k >= nA) return false; band_make_a(p, 2, c + k * G, D); return true; }
    if (k >= nB) return false; band_make_b(p, c + k * G, D); return true;
}
template <int KIND> __device__ __forceinline__ void band_prefetch(const Params& p, bf16x8 (&sk)[8], bf16x8 (&sv)[8], int tid) {
    constexpr int W = KIND == BK_B ? 128 : 64; const int sr = tid >> 3, sc = tid & 7; BandU D;
    if (band_item<KIND>(p, 0, D)) {
#pragma unroll
        for (int it = 0; it < 6; ++it) { int jk = D.Q0 - W + it * 64 + sr; jk = jk < 0 ? 0 : (jk >= D.L ? D.L - 1 : jk);
            sk[it] = *(const bf16x8*)(D.k + (size_t)jk * D.rs + sc * 8); sv[it] = *(const bf16x8*)(D.v + (size_t)jk * D.rs + sc * 8); } }
}
template <int KIND, int NEXT> __device__ __forceinline__ void band_run(const Params& p, int layer, ALAS unsigned char* lds, bf16x8 (&sk)[8], bf16x8 (&sv)[8], bool pre) {
    constexpr int NTILE = KIND == BK_B ? 8 : 6, NTW = KIND == BK_B ? 5 : 3, W = KIND == BK_B ? 128 : 64, NH = KIND == BK_B ? 3 : 1;
    constexpr int NPF = 6;
    constexpr bool PREFETCH = KIND != BK_B;
    const int tid = tid_opaque(), wid = __builtin_amdgcn_readfirstlane(tid >> 6), lane = tid & 63, r32 = lane & 31, hi = lane >> 5;
    ALAS unsigned char* K_lds = lds; ALAS unsigned char* V_lds = lds + BL_V;
    ALAS float* wsf = (ALAS float*)(lds + BL_WS) + wid * 128; ALAS float* li_l = wsf; ALAS float* al_l = wsf + 32;
    ALAS bf16_t* stg = (ALAS bf16_t*)(lds + BL_STG) + wid * 1024;
    const int vb0 = (int)(uintptr_t)V_lds + v_rd_base(lane);
    const int sr = tid >> 3, sc = tid & 7;
    const float ninf = -__builtin_inff();
    const bf16_t* proj = (const bf16_t*)(p.ws + WS_PROJ); bf16_t* ym = (bf16_t*)(p.ws + WS_YMIX);
    BandU D; int k = 0; bool have = band_item<KIND>(p, 0, D);
#define BAND_LOADR(DD, I0, I1) do { _Pragma("unroll") for (int it = (I0); it < (I1); ++it) { int jk = (DD).Q0 - W + it * 64 + sr; jk = jk < 0 ? 0 : (jk >= (DD).L ? (DD).L - 1 : jk); \
        sk[it] = *(const bf16x8*)((DD).k + (size_t)jk * (DD).rs + sc * 8); sv[it] = *(const bf16x8*)((DD).v + (size_t)jk * (DD).rs + sc * 8); } } while (0)
    if (have) { if (!pre) BAND_LOADR(D, 0, NTILE); else BAND_LOADR(D, 6, NTILE); }
    else { if constexpr (NEXT >= 0) band_prefetch<NEXT>(p, sk, sv, tid); }
    while (have) {
#pragma unroll
        for (int it = 0; it < NTILE; ++it) { *(ALAS bf16x8*)(K_lds + it * BL_KT + sr * KP64 + sc * 16) = sk[it]; *(ALAS bf16x8*)(V_lds + it * VTB + v_st(sr, sc * 8)) = sv[it]; }
        const int jq = D.Q0 + wid * 32 + r32;
        const size_t tokl = D.tok0 + (size_t)D.d * jq;
        bf16x8 qr[4];
#pragma unroll
        for (int d0 = 0; d0 < 4; ++d0) qr[d0] = *(const bf16x8*)(D.q + (size_t)jq * D.rs + d0 * 16 + hi * 8);
        __syncthreads();
        const int lo_i = (-W > -jq) ? -W : -jq, hi_i = (W < D.L - 1 - jq) ? W : D.L - 1 - jq;
        const float midf = 0.5f * (float)(lo_i + hi_i), hwf = 0.5f * (float)(hi_i - lo_i);
#pragma unroll 1
        for (int hh = 0; hh < NH; ++hh) {
            const int hcur = D.h + hh; const float slope2 = (KIND == BK_B) ? slope_all(hcur) * LOG2E : D.slope2;
            float m_reg = -1e30f, l_reg = 0.f; f32x16 o[2]; o[0] = f32x16{}; o[1] = f32x16{};
#pragma unroll 1
            for (int jj = 0; jj < NTW; ++jj) { const int jt = (wid >> 1) + jj;
                f32x16 p0, p1; float alpha; bf16x8 pa[4], VF[4];
                band_qk(p0, p1, qr, K_lds + jt * BL_KT + r32 * KP64 + hi * 16);
                const int vbt = vb0 + jt * VTB;
                VF[0] = bv_frag<0>(vbt); VF[1] = bv_frag<1>(vbt); VF[2] = bv_frag<2>(vbt); VF[3] = bv_frag<3>(vbt); SBAR();
                const float relb = (float)(64 * jt - W - 32 * wid - r32 + 4 * hi);
                const int kt0 = D.Q0 - W + 64 * jt;
                const bool interior = (64 * jt >= 32 * wid + 31) && (64 * jt + 63 <= 2 * W + 32 * wid) && (kt0 >= 0) && (kt0 + 63 < D.L);
                asm volatile("s_nop 15\n\ts_nop 7" : "+v"(p0), "+v"(p1));
                const float nsl = -slope2;
                if (interior) { band_bias<0>(p0, p1, relb, nsl);
                } else { band_bias_mask<0>(p0, p1, relb, relb - midf, hwf, nsl, ninf); }
                partialSM(p0, p1, m_reg, alpha);
                ATT_RESC(alpha, al_l);
                finishSM(p0, p1, alpha, l_reg, pa[0], pa[1], pa[2], pa[3]); SBAR();
                BandPV<0>::run(o, VF, pa, vbt);
            }
            if (PREFETCH) { BandU Dn; if (band_item<KIND>(p, k + 1, Dn)) BAND_LOADR(Dn, 0, NPF); else if constexpr (NEXT >= 0) band_prefetch<NEXT>(p, sk, sv, tid); }
            u32x4 gpre[2][2], f1pre[2][2], f2pre[2][2]; float l1 = 0.f, l2 = 0.f;
            if (KIND == BK_A_MERGE) { l1 = ((const float*)(p.ws + WS_LSE1))[tokl * 4 + hcur]; l2 = ((const float*)(p.ws + WS_LSE2))[tokl * 4 + hcur]; }
#pragma unroll
            for (int i = 0; i < 2; ++i) { const size_t tok = D.tok0 + (size_t)D.d * (D.Q0 + wid * 32 + i * 16 + (lane >> 2));
#pragma unroll
                for (int d0 = 0; d0 < 2; ++d0) { const int col = d0 * 32 + (lane & 3) * 8;
                    if (KIND == BK_B) gpre[d0][i] = *(const u32x4*)(proj + tok * NP + C_GB + hcur * 64 + col);
                    if (KIND == BK_A_MERGE) { gpre[d0][i] = *(const u32x4*)(proj + tok * NP + C_GA + hcur * 64 + col);
                        f1pre[d0][i] = *(const u32x4*)((const bf16_t*)(p.ws + WS_OA1) + tok * 256 + hcur * 64 + col); f2pre[d0][i] = *(const u32x4*)((const bf16_t*)(p.ws + WS_OA2) + tok * 256 + hcur * 64 + col); } } }
            float mult;
            if (KIND == BK_B) { const float sk2 = p.sink[layer * 6 + hcur] * LOG2E, M = fmaxf(m_reg, sk2), e = __builtin_amdgcn_exp2f(m_reg - M), den = l_reg * e + __builtin_amdgcn_exp2f(sk2 - M); mult = e / den; }
            else mult = 1.f / l_reg;
            if (hi == 0) li_l[r32] = mult;
            if (KIND == BK_A_PART) { if (hi == 0) D.lsepart[tokl * 4 + hcur] = m_reg + __builtin_amdgcn_logf(l_reg); }
            if (KIND == BK_A_MERGE) { if (hi == 0) { const float l3 = m_reg + __builtin_amdgcn_logf(l_reg);
                    const float Mx = fmaxf(fmaxf(l1, l2), l3), e1 = __builtin_amdgcn_exp2f(l1 - Mx), e2 = __builtin_amdgcn_exp2f(l2 - Mx), e3 = __builtin_amdgcn_exp2f(l3 - Mx), inv = 1.f / (e1 + e2 + e3);
                    wsf[32 + r32] = e1 * inv; wsf[64 + r32] = e2 * inv; wsf[96 + r32] = e3 * inv; } }
            asm volatile("s_waitcnt lgkmcnt(0)" ::: "memory");
#pragma unroll
            for (int d0 = 0; d0 < 2; ++d0) {
#pragma unroll
                for (int r = 0; r < 16; ++r) stg[crow(r, hi) * 32 + r32] = (bf16_t)f2bf(o[d0][r] * li_l[crow(r, hi)]);
                asm volatile("s_waitcnt lgkmcnt(0)" ::: "memory");
#pragma unroll
                for (int i = 0; i < 2; ++i) { const int row = i * 16 + (lane >> 2), ch = lane & 3, col = d0 * 32 + ch * 8; const size_t tok = D.tok0 + (size_t)D.d * (D.Q0 + wid * 32 + row);
                    const u32x4 ov = *(const ALAS u32x4*)(stg + row * 32 + ch * 8);
                    if (KIND == BK_A_PART) { *(u32x4*)(D.opart + tok * 256 + hcur * 64 + col) = ov; }
                    else { float of[8], gf[8]; unpack8(ov, of);
                        if (KIND == BK_A_MERGE) { const float w1 = wsf[32 + row], w2 = wsf[64 + row], w3 = wsf[96 + row]; float f1[8], f2[8]; unpack8(f1pre[d0][i], f1); unpack8(f2pre[d0][i], f2);
#pragma unroll
                            for (int j = 0; j < 8; ++j) of[j] = w3 * of[j] + w1 * f1[j] + w2 * f2[j]; }
                        unpack8(gpre[d0][i], gf);
#pragma unroll
                        for (int j = 0; j < 8; ++j) of[j] *= silu_f(gf[j]);
                        *(u32x4*)(ym + tok * DM + (KIND == BK_B ? 256 : 0) + hcur * 64 + col) = pack8(of); } }
                asm volatile("s_waitcnt lgkmcnt(0)" ::: "memory"); }
            if (hh + 1 < NH) {
#pragma unroll
                for (int d0 = 0; d0 < 4; ++d0) qr[d0] = *(const bf16x8*)(D.q + (size_t)jq * D.rs + (hh + 1) * 64 + d0 * 16 + hi * 8); }
        }
        __syncthreads();
        ++k;
        have = band_item<KIND>(p, k, D); if (!PREFETCH && have) BAND_LOADR(D, 0, NTILE);
    }
#undef BAND_LOADR
}
#undef SBAR
}

constexpr int LDS_BYTES = 163840;
#define LAS __attribute__((address_space(3)))
__device__ __forceinline__ const bf16_t* w_in_t(const Params& p, int l) { return (const bf16_t*)(p.ws + WS_WIN) + (size_t)l * NP * DM; }
__device__ __forceinline__ const bf16_t* w_uq_t(const Params& p, int l) { return (const bf16_t*)(p.ws + WS_WUQ) + (size_t)l * 768 * 256; }
__device__ __forceinline__ const bf16_t* w_ukv_t(const Params& p, int l) { return (const bf16_t*)(p.ws + WS_WUKV) + (size_t)l * 768 * 256; }
__device__ __forceinline__ const bf16_t* w_o_t(const Params& p, int l) { return (const bf16_t*)(p.ws + WS_WO) + (size_t)l * DM * DM; }

__device__ __forceinline__ void ph_gemm1(const Params& p, int layer, LAS unsigned char* lds) {
    pg8::Gemm g{(const bf16_t*)(p.ws + WS_XB), w_in_t(p, layer), DM, DM, DM};
    pg8::StaticOrder S; S.init(T, NP, (int)gridDim.x, (int)blockIdx.x, WGM_GEMM1);
    typedef pg8::EpiWrap<EpProj, true> E_t; E_t E{EpProj{(bf16_t*)(p.ws + WS_PROJ)}, (float*)(p.ws + WS_PARTQ), (float*)(p.ws + WS_PARTKV)};
    pg8::gemm_phase<E_t, pg8::StaticOrder, true, true>(lds, g, S, E);
}
__device__ __forceinline__ void ph_up(const Params& p, int layer, LAS unsigned char* lds) {
    { pg8::Gemm g{(const bf16_t*)(p.ws + WS_PROJ) + C_CQ, w_uq_t(p, layer), NP, 256, 256};
      pg8::RangeOrder S; S.init(0, 384, 3, (int)gridDim.x, (int)blockIdx.x);
      typedef pg8::EpiWrap<EpQ, false, true> E_t; E_t E{EpQ{(bf16_t*)(p.ws + WS_QC), (const float*)(p.ws + WS_PARTQ)}, nullptr, nullptr};
      pg8::gemm_phase<E_t, pg8::RangeOrder, true, true>(lds, g, S, E); }
    { pg8::Gemm g{(const bf16_t*)(p.ws + WS_PROJ) + C_CKV, w_ukv_t(p, layer), NP, 256, 256};
      pg8::RangeOrder S; S.init(384, 384, 3, (int)gridDim.x, (int)blockIdx.x);
      typedef pg8::EpiWrap<EpKV, false, true> E_t; E_t E{EpKV{(bf16_t*)(p.ws + WS_KC), (bf16_t*)(p.ws + WS_VC), (const float*)(p.ws + WS_PARTKV)}, nullptr, nullptr};
      pg8::gemm_phase<E_t, pg8::RangeOrder, true, true>(lds, g, S, E); }
}
__device__ __forceinline__ void ph_out(const Params& p, int layer, LAS unsigned char* lds) {
    pg8::Gemm g{(const bf16_t*)(p.ws + WS_YMIX), w_o_t(p, layer), DM, DM, DM};
    pg8::StaticOrder S; S.init(T, DM, (int)gridDim.x, (int)blockIdx.x, WGM_OUT);
    typedef pg8::EpiWrap<EpY, false> E_t; E_t E{EpY{(bf16_t*)(p.ws + WS_Y)}, nullptr, nullptr};
    pg8::gemm_phase<E_t, pg8::StaticOrder, true, true>(lds, g, S, E);
}
#define XB_TMO      128
#define XB_XCNT(j)  (256  + 64 * (j))
#define XB_XSUB(j)  (1280 + 64 * (j))
#define XB_XGEN(j)  (2304 + 64 * (j))
#define XB_TOP      3328
#define XB_TOPGEN   3392
#define XCD_BAR_WORDS 3456
#define XB_SPIN_CAP (1u << 21)

__device__ __forceinline__ unsigned xb_ld(unsigned* p)              { return __hip_atomic_load(p, __ATOMIC_RELAXED, __HIP_MEMORY_SCOPE_AGENT); }
__device__ __forceinline__ unsigned xb_add(unsigned* p, unsigned v) { return __hip_atomic_fetch_add(p, v, __ATOMIC_RELAXED, __HIP_MEMORY_SCOPE_AGENT); }
__device__ __forceinline__ unsigned xb_xcc_id() { return (unsigned)__builtin_amdgcn_s_getreg((3 << 11) | 20) & 0xFu; }
#define XB_SPIN(cond, bar) do { unsigned _sp = 0; while (cond) { __builtin_amdgcn_s_sleep(1); \
    if ((++_sp & 255u) == 0u) { if (xb_ld(&(bar)[XB_TMO])) break; if (_sp > XB_SPIN_CAP) { atomicAdd(&(bar)[XB_TMO], 1u); break; } } } } while (0)

struct XcdBarrier {
    unsigned* bar; unsigned x;
    volatile LAS unsigned* st;
};

__device__ __forceinline__ XcdBarrier xcd_barrier_post(unsigned* bar, volatile LAS unsigned* st) {
    XcdBarrier b; b.bar = bar; b.x = xb_xcc_id(); b.st = st;
    if (threadIdx.x == 0) (void)xb_add(&bar[XB_XCNT(b.x)], 1u);
    return b;
}
__device__ __forceinline__ void xcd_barrier_complete(unsigned* bar, unsigned x, unsigned& nloc, unsigned& nx) {
    const unsigned G = gridDim.x * gridDim.y * gridDim.z;
    unsigned sum, cnt, mine, sp = 0u;
    for (;;) {
        sum = 0u; cnt = 0u; mine = 0u;
#pragma unroll
        for (unsigned j = 0; j < 16; ++j) { const unsigned c = xb_ld(&bar[XB_XCNT(j)]); sum += c; cnt += (c > 0u) ? 1u : 0u; mine = (j == x) ? c : mine; }
        if (sum == G) break;
        __builtin_amdgcn_s_sleep(1);
        if ((++sp & 255u) == 0u) { if (xb_ld(&bar[XB_TMO])) break; if (sp > XB_SPIN_CAP) { atomicAdd(&bar[XB_TMO], 1u); break; } }
    }
    nloc = mine > 0u ? mine : 1u; nx = cnt > 0u ? cnt : 1u;
}

__device__ __forceinline__ void xcd_barrier(const XcdBarrier& b) {
    asm volatile("s_waitcnt vmcnt(0)" ::: "memory");
    __syncthreads();
    if (threadIdx.x == 0) {
        unsigned* bar = b.bar;
        __builtin_amdgcn_s_waitcnt(0);
        unsigned nloc = b.st[0], nx = b.st[1];
        if (nloc == 0u) { xcd_barrier_complete(bar, b.x, nloc, nx); b.st[0] = nloc; b.st[1] = nx; }
        const unsigned old = xb_add(&bar[XB_XSUB(b.x)], 1u);
        const unsigned gen = old / nloc;
        if (old + 1u == (gen + 1u) * nloc) {
            __builtin_amdgcn_fence(__ATOMIC_RELEASE, "agent");
            asm volatile("s_waitcnt vmcnt(0)" ::: "memory");
            const unsigned og = xb_add(&bar[XB_TOP], 1u);
            const unsigned tg = og / nx;
            if (og + 1u == (tg + 1u) * nx) xb_add(&bar[XB_TOPGEN], 1u);
            else XB_SPIN(xb_ld(&bar[XB_TOPGEN]) == tg, bar);
            __builtin_amdgcn_fence(__ATOMIC_ACQUIRE, "agent");
            xb_add(&bar[XB_XGEN(b.x)], 1u);
            asm volatile("s_waitcnt vmcnt(0)" ::: "memory");
        } else {
            XB_SPIN(xb_ld(&bar[XB_XGEN(b.x)]) == gen, bar);
            __builtin_amdgcn_fence(__ATOMIC_ACQUIRE, "agent");
            asm volatile("s_waitcnt vmcnt(0)" ::: "memory");
        }
    }
    __syncthreads();
}

#ifndef MEGA
#define MEGA 1
#endif
#define REP_P0 1
#define REP_GEMM1 1
#define REP_P2 1
#define REP_P3 1
#define REP_UP 1
#define REP_A12 1
#define REP_C 1
#define REP_A3 1
#define REP_OUT 1
#define REP_SYNC 1
__global__ void __launch_bounds__(512, 2) mega_fwd(Params p) {
    extern __shared__ __attribute__((aligned(16))) unsigned char dlds[];
    cooperative_groups::grid_group grid = cooperative_groups::this_grid();
    LAS unsigned char* lds = (LAS unsigned char*)dlds;
    volatile LAS unsigned* bst = (volatile LAS unsigned*)(lds + LDS_BYTES - 64);
    if (threadIdx.x < 16) bst[threadIdx.x] = 0u;
    __syncthreads();
    (void)xcd_barrier_post((unsigned*)(p.ws + WS_CTL), bst);
    if (p.ws == nullptr) grid.sync();
#define GRID_SYNC() do { XcdBarrier b_; b_.bar = (unsigned*)(p.ws + WS_CTL); b_.x = xb_xcc_id(); b_.st = (volatile LAS unsigned*)((LAS unsigned char*)dlds + LDS_BYTES - 64); xcd_barrier(b_); } while (0)
#define GT_NG() const int tid_ = tid_opaque(), gt = blockIdx.x * 512 + tid_, ng = gridDim.x * 512, lane = tid_ & 63
    for (int rep = 0; rep < REP_P0; ++rep) {
    GT_NG();
    prologue_weights<512>(p, (float*)dlds, blockIdx.x, gridDim.x);
    prologue_rope(p, gt, ng);
    row_pass<0>(p.x, nullptr, nullptr, nullptr, nullptr, (bf16_t*)(p.ws + WS_XB), (float*)(p.ws + WS_RINV), gt >> 6, ng >> 6, lane); }
    for (int rep = 0; rep < REP_SYNC; ++rep) GRID_SYNC();
#define MEGA_LAYER(l) do { \
        for (int rep = 0; rep < REP_GEMM1; ++rep) ph_gemm1(p, l, lds); \
        for (int rep = 0; rep < REP_SYNC; ++rep) GRID_SYNC(); \
        for (int rep = 0; rep < REP_P2; ++rep) { \
        { GT_NG(); (void)lane; kr_rope_pass(p, gt, ng); } \
        for (int r2 = 0; r2 < REP_UP; ++r2) ph_up(p, l, lds); \
        { att::bf16x8 bsk_[8], bsv_[8]; att::band_run<att::BK_A_PART, att::BK_B>(p, l, lds, bsk_, bsv_, false); att::band_run<att::BK_B, -1>(p, l, lds, bsk_, bsv_, true); } } \
        for (int rep = 0; rep < REP_SYNC; ++rep) GRID_SYNC(); \
        for (int rep = 0; rep < REP_P3; ++rep) { \
        { const int G_ = gridDim.x, bx_ = blockIdx.x, vcu_ = (G_ % 8 == 0) ? (bx_ % 8) * (G_ / 8) + bx_ / 8 : bx_; \
          att::bf16x8 bsk_[8], bsv_[8]; att::attn_c_run(p, vcu_, G_, lds, bsk_, bsv_); att::band_run<att::BK_A_MERGE, -1>(p, l, lds, bsk_, bsv_, false); } } \
        for (int rep = 0; rep < REP_SYNC; ++rep) GRID_SYNC(); \
        for (int rep = 0; rep < REP_OUT; ++rep) ph_out(p, l, lds); \
        for (int rep = 0; rep < REP_SYNC; ++rep) GRID_SYNC(); \
        GT_NG(); \
        static_assert(DEPTH == 2, "the residual stream is carried from layer 0 to layer 1 as xb * rinv"); \
        if (l == 0) row_pass<1>(nullptr, (const bf16_t*)(p.ws + WS_XB), (const bf16_t*)(p.ws + WS_Y), p.post_norm, nullptr, (bf16_t*)(p.ws + WS_XB), (float*)(p.ws + WS_RINV), gt >> 6, ng >> 6, lane); \
        else row_pass<2>(nullptr, (const bf16_t*)(p.ws + WS_XB), (const bf16_t*)(p.ws + WS_Y), p.post_norm + l * DM, p.out, nullptr, (float*)(p.ws + WS_RINV), gt >> 6, ng >> 6, lane); \
    } while (0)
    MEGA_LAYER(0);
    for (int rep = 0; rep < REP_SYNC; ++rep) GRID_SYNC();
    MEGA_LAYER(1);
    static_assert(DEPTH == 2, "two layers, each its own copy of the layer body");
#undef MEGA_LAYER
}

extern "C" void kernel_launch(void* const* d_in, const int* in_sizes, int n_in, void* d_out, int out_size, void* d_ws, size_t ws_size, hipStream_t stream) {
    if (n_in != 11 || in_sizes[0] != T * DM || out_size != T * DM || ws_size < WS_END) { fprintf(stderr, "kernel_launch: shape/ws mismatch (ws %zu, need %zu)\n", ws_size, (size_t)WS_END); return; }
    Params p{};
    p.x = (const float*)d_in[0]; p.pos = (const int*)d_in[1]; p.pre_norm = (const float*)d_in[2]; p.w_in = (const float*)d_in[3]; p.q_norm = (const float*)d_in[4];
    p.kv_norm = (const float*)d_in[5]; p.w_uq = (const float*)d_in[6]; p.w_ukv = (const float*)d_in[7]; p.sink = (const float*)d_in[8]; p.w_o = (const float*)d_in[9];
    p.post_norm = (const float*)d_in[10]; p.out = (float*)d_out; p.ws = (unsigned char*)d_ws;
    unsigned char* ws = p.ws; (void)ws;
#if MEGA
    static int grid_blocks = 0;
    if (grid_blocks == 0) {
        int dev = 0, cus = 0, per_cu = 0;
        if (hipGetDevice(&dev) != hipSuccess || hipDeviceGetAttribute(&cus, hipDeviceAttributeMultiprocessorCount, dev) != hipSuccess) { fprintf(stderr, "kernel_launch: device query failed\n"); grid_blocks = -1; return; }
        if (hipFuncSetAttribute((const void*)mega_fwd, hipFuncAttributeMaxDynamicSharedMemorySize, LDS_BYTES) != hipSuccess) { fprintf(stderr, "kernel_launch: hipFuncSetAttribute failed\n"); grid_blocks = -1; return; }
        if (hipOccupancyMaxActiveBlocksPerMultiprocessor(&per_cu, (const void*)mega_fwd, 512, LDS_BYTES) != hipSuccess || per_cu < 1) { fprintf(stderr, "kernel_launch: occupancy query says %d blocks per CU\n", per_cu); (void)hipGetLastError(); per_cu = 1; }
        grid_blocks = cus * 1;
        fprintf(stderr, "kernel_launch: %d CUs, occupancy query %d per CU, grid %d\n", cus, per_cu, grid_blocks);
    }
    if (grid_blocks < 0) return;
    if (hipMemsetAsync((char*)d_ws + WS_CTL, 0, 65536, stream) != hipSuccess) { fprintf(stderr, "kernel_launch: memset failed\n"); return; }
    void* args[] = {(void*)&p};
    const hipError_t e = hipLaunchCooperativeKernel((const void*)mega_fwd, dim3(grid_blocks), dim3(512), args, LDS_BYTES, stream);
    if (e != hipSuccess) fprintf(stderr, "kernel_launch: cooperative launch failed: %s (grid %d)\n", hipGetErrorString(e), grid_blocks);
#endif
}
```

```cpp
#include <hip/hip_runtime.h>
#include <hip/hip_cooperative_groups.h>
#include <cstdint>
#include <cstdio>
#define WGM_GEMM1 4
#define WGM_OUT 4

constexpr int NBATCH = 8, SEQ = 4096, T = NBATCH * SEQ, DM = 1024, DIN = 2848, NP = 3072, DEPTH = 2;
constexpr int C_QA = 0, C_KA = 256, C_VA = 512, C_GA = 768, C_QB = 1024, C_KB = 1408, C_VB = 1536, C_GB = 1664,
              C_CQ = 2048, C_CKV = 2304, C_KR = 2432, C_GC = 2464;
constexpr int QC_LD = 576, KC_LD = 384, VC_LD = 384;
constexpr float LOG2E = 1.4426950408889634f;
constexpr float QS_AB = 0.125f * LOG2E;
constexpr float QS_C = 0.10206207261596575f * LOG2E;
constexpr float RMS_EPS = 1e-6f;

typedef unsigned short bf16_t;
typedef float f32x4 __attribute__((ext_vector_type(4)));
typedef unsigned u32x4 __attribute__((ext_vector_type(4)));
typedef unsigned u32x2 __attribute__((ext_vector_type(2)));

__device__ __forceinline__ int tid_opaque() { int t = threadIdx.x; asm volatile("" : "+v"(t)); return t; }
__device__ __forceinline__ float bf2f(bf16_t b) { return __uint_as_float((unsigned)b << 16); }
typedef float f32x2_t __attribute__((ext_vector_type(2))); typedef __bf16 bf16x2_t __attribute__((ext_vector_type(2)));
__device__ __forceinline__ unsigned pk2(float lo, float hi) { const f32x2_t v = {lo, hi}; const bf16x2_t b = __builtin_convertvector(v, bf16x2_t); return __builtin_bit_cast(unsigned, b); }
__device__ __forceinline__ unsigned f2bf(float f) { return pk2(f, 0.f) & 0xffffu; }
__device__ __forceinline__ float silu_f(float g) { return g * __builtin_amdgcn_rcpf(1.f + __builtin_amdgcn_exp2f(-g * LOG2E)); }
__device__ __forceinline__ int rope_perm(int r) { return r < 16 ? 2 * r : 2 * (r - 16) + 1; }
__device__ __forceinline__ float slope_all(int i) { return __builtin_amdgcn_exp2f(-0.8f * (float)(i + 1)); }

constexpr size_t MiB = 1u << 20;
constexpr size_t WS_CTL = 0;
constexpr size_t WS_WIN = 2 * MiB;
constexpr size_t WS_WUQ = 14 * MiB;
constexpr size_t WS_WUKV = 15 * MiB;
constexpr size_t WS_WO = 16 * MiB;
constexpr size_t WS_CS = 20 * MiB;
constexpr size_t WS_PARTQ = 24 * MiB;
constexpr size_t WS_PARTKV = 25 * MiB;
constexpr size_t WS_LSE1 = 26 * MiB;
constexpr size_t WS_LSE2 = 27 * MiB;
constexpr size_t WS_RINV = 28 * MiB;
constexpr size_t WS_XB = 32 * MiB;
constexpr size_t WS_PROJ = 96 * MiB;
constexpr size_t WS_QC = 288 * MiB;
constexpr size_t WS_KC = 324 * MiB;
constexpr size_t WS_VC = 360 * MiB;
constexpr size_t WS_OA1 = 384 * MiB;
constexpr size_t WS_OA2 = 400 * MiB;
constexpr size_t WS_YMIX = 416 * MiB;
constexpr size_t WS_Y = 96 * MiB;
constexpr size_t WS_KR = 480 * MiB;
constexpr size_t WS_END = 482 * MiB;

__host__ __device__ __forceinline__ constexpr size_t y_off(size_t m) { return (m >> 12) * ((size_t)4096 * 3072) + (m & 4095) * (size_t)1024; }
struct Params {
    const float* x; const int* pos; const float* pre_norm; const float* w_in; const float* q_norm; const float* kv_norm;
    const float* w_uq; const float* w_ukv; const float* sink; const float* w_o; const float* post_norm;
    float* out; unsigned char* ws;
};

struct PTile { const float* W; const float* g; bf16_t* WT; int N, ldk, k0, n0, kind; };
constexpr int TL_IN = 16 * 45, TL_UQ = 4 * 9, TL_UKV = 2 * 12, TL_O = 16 * 16, TL_LAYER = TL_IN + TL_UQ + TL_UKV + TL_O;
__device__ __forceinline__ PTile ptile_desc(const Params& p, int it) {
    const int l = it / TL_LAYER; int r = it % TL_LAYER; PTile t; int ntn;
    if (r < TL_IN) { t.W = p.w_in + (size_t)l * DM * DIN; t.g = p.pre_norm + l * DM; t.WT = (bf16_t*)(p.ws + WS_WIN) + (size_t)l * NP * DM; t.N = DIN; t.ldk = DM; t.kind = 0; ntn = 45; }
    else if ((r -= TL_IN) < TL_UQ) { t.W = p.w_uq + (size_t)l * 256 * 576; t.g = p.q_norm + l * 256; t.WT = (bf16_t*)(p.ws + WS_WUQ) + (size_t)l * 768 * 256; t.N = 576; t.ldk = 256; t.kind = 1; ntn = 9; }
    else if ((r -= TL_UQ) < TL_UKV) { t.W = p.w_ukv + (size_t)l * 128 * 768; t.g = p.kv_norm + l * 128; t.WT = (bf16_t*)(p.ws + WS_WUKV) + (size_t)l * 768 * 256; t.N = 768; t.ldk = 256; t.kind = 2; ntn = 12; }
    else { r -= TL_UKV; t.W = p.w_o + (size_t)l * DM * DM; t.g = nullptr; t.WT = (bf16_t*)(p.ws + WS_WO) + (size_t)l * DM * DM; t.N = DM; t.ldk = DM; t.kind = 3; ntn = 16; }
    t.k0 = (r / ntn) * 64; t.n0 = (r % ntn) * 64; return t;
}
template <int NTH> __device__ __forceinline__ void ptile_load(const PTile& t, float (&v)[8]) {
    const int tid = threadIdx.x; constexpr int RPI = NTH / 64; static_assert(64 / RPI == 8, "8 rows of the tile per thread");
#pragma unroll
    for (int i = 0; i < 8; ++i) { const int kk = i * RPI + (tid >> 6), n = t.n0 + (tid & 63);
        v[i] = 0.f; if (n < t.N) v[i] = t.W[(size_t)(t.k0 + kk) * t.N + n] * (t.g ? t.g[t.k0 + kk] : 1.f); }
}
template <int KIND, int NTH> __device__ __forceinline__ void ptile_store(const PTile& t, const float* lds) {
    const int tid = threadIdx.x; constexpr int RPI = NTH / 64;
#pragma unroll
    for (int i = 0; i < 64 / RPI; ++i) { const int nn = i * RPI + (tid >> 6), kk = tid & 63, n = t.n0 + nn;
        if (n < t.N) { int dst = n; float sc = 1.f;
            if (KIND == 0) { if (n < 256 || (n >= C_QB && n < C_KB)) sc = QS_AB; if (n >= C_KR && n < C_GC) dst = C_KR + rope_perm(n - C_KR); }
            if (KIND == 1) { sc = QS_C; const int h = n / 96, w = n % 96; dst = h * 96 + (w < 64 ? w : 64 + rope_perm(w - 64)); }
            if (KIND == 2) { const int h = n / 128, w = n % 128; dst = (w < 64) ? h * 64 + w : 384 + h * 64 + (w - 64); }
            t.WT[(size_t)dst * t.ldk + t.k0 + kk] = (bf16_t)f2bf(lds[kk * 65 + nn] * sc); } }
}
__device__ __forceinline__ void prologue_rope_item(const Params& p, int i, int posv) {
    const int f = i & 15;
    const float freq = __builtin_amdgcn_exp2f(-(float)f * (13.287712379549449f / 16.f));
    const float ang = (float)posv * freq;
    double rev = (double)ang * 0.15915494309189535; rev -= __builtin_rint(rev);
    const float rv = (float)rev;
    ((float2*)(p.ws + WS_CS))[i] = make_float2(__builtin_amdgcn_cosf(rv), __builtin_amdgcn_sinf(rv));
}
__device__ __forceinline__ void prologue_rope(const Params& p, int gt, int ng) {
    float2* cs = (float2*)(p.ws + WS_CS);
    for (int i = gt; i < T * 16; i += ng) { const int t = i >> 4, f = i & 15;
        const float freq = __builtin_amdgcn_exp2f(-(float)f * (13.287712379549449f / 16.f));
        const float ang = (float)p.pos[t] * freq;
        double rev = (double)ang * 0.15915494309189535; rev -= __builtin_rint(rev);
        const float rv = (float)rev;
        cs[i] = make_float2(__builtin_amdgcn_cosf(rv), __builtin_amdgcn_sinf(rv)); }
}
__device__ __forceinline__ float wave_sum(float v) {
#pragma unroll
    for (int o = 1; o < 64; o <<= 1) v += __shfl_xor(v, o);
    return v;
}
template <int MODE>
__device__ __forceinline__ void row_pass(const float* x, const bf16_t* xbin, const bf16_t* y, const float* g, float* out, bf16_t* xb, float* rinv, int gw, int ngw, int lane, int trip0 = 0, int ntrip = 1 << 30) {
    constexpr int R = 2;
    for (int m0 = gw + trip0 * R * ngw, tc = 0; m0 < T && tc < ntrip; m0 += R * ngw, ++tc) {
        f32x4 v[R][4], w[R][4]; float ri[R];
#pragma unroll
        for (int rr = 0; rr < R; ++rr) { const int m = m0 + rr * ngw; if (m < T) {
            if (MODE >= 1) { const u32x4* xr = (const u32x4*)(xbin + (size_t)m * DM) + lane; ri[rr] = rinv[m];
#pragma unroll
                for (int jj = 0; jj < 2; ++jj) { const u32x4 xx = xr[64 * jj]; v[rr][2 * jj] = (f32x4){__uint_as_float(xx.x << 16), __uint_as_float(xx.x & 0xffff0000u), __uint_as_float(xx.y << 16), __uint_as_float(xx.y & 0xffff0000u)};
                    v[rr][2 * jj + 1] = (f32x4){__uint_as_float(xx.z << 16), __uint_as_float(xx.z & 0xffff0000u), __uint_as_float(xx.w << 16), __uint_as_float(xx.w & 0xffff0000u)}; } }
            else { const f32x4* xr = (const f32x4*)(x + (size_t)m * DM) + lane;
#pragma unroll
                for (int j = 0; j < 4; ++j) v[rr][j] = xr[64 * j]; }
            if (MODE >= 1) { const u32x4* yr = (const u32x4*)(y + (size_t)m * DM) + lane;
#pragma unroll
                for (int jj = 0; jj < 2; ++jj) { const u32x4 yy = yr[64 * jj]; w[rr][2 * jj] = (f32x4){__uint_as_float(yy.x << 16), __uint_as_float(yy.x & 0xffff0000u), __uint_as_float(yy.y << 16), __uint_as_float(yy.y & 0xffff0000u)};
                    w[rr][2 * jj + 1] = (f32x4){__uint_as_float(yy.z << 16), __uint_as_float(yy.z & 0xffff0000u), __uint_as_float(yy.w << 16), __uint_as_float(yy.w & 0xffff0000u)}; } } } }
#pragma unroll
        for (int rr = 0; rr < R; ++rr) { const int m = m0 + rr * ngw; if (m < T) {
            if (MODE >= 1) {
#pragma unroll
                for (int j = 0; j < 4; ++j) v[rr][j] = v[rr][j] * ri[rr]; }
            if (MODE >= 1) { float s = 0.f;
#pragma unroll
                for (int j = 0; j < 4; ++j) s += (w[rr][j].x * w[rr][j].x + w[rr][j].y * w[rr][j].y) + (w[rr][j].z * w[rr][j].z + w[rr][j].w * w[rr][j].w);
                const float rs = 1.f / sqrtf(wave_sum(s) * (1.f / DM) + RMS_EPS);
#pragma unroll
                for (int j = 0; j < 4; ++j) { const int c4 = (j >> 1) * 128 + lane * 2 + (j & 1);
                    const f32x4 gg = ((const f32x4*)g)[c4]; v[rr][j] = v[rr][j] + w[rr][j] * rs * gg; if (MODE == 2) ((f32x4*)(out + (size_t)m * DM))[c4] = v[rr][j]; } }
            if (MODE <= 1) { float s = 0.f;
#pragma unroll
                for (int j = 0; j < 4; ++j) s += (v[rr][j].x * v[rr][j].x + v[rr][j].y * v[rr][j].y) + (v[rr][j].z * v[rr][j].z + v[rr][j].w * v[rr][j].w);
                const float ms = sqrtf(wave_sum(s) * (1.f / DM) + RMS_EPS), rs = 1.f / ms;
                if (lane == 0) rinv[m] = ms;
                if (MODE == 1) { u32x4* o16 = (u32x4*)(xb + (size_t)m * DM) + lane;
#pragma unroll
                    for (int jj = 0; jj < 2; ++jj) { u32x4 o; o.x = pk2(v[rr][2 * jj].x * rs, v[rr][2 * jj].y * rs); o.y = pk2(v[rr][2 * jj].z * rs, v[rr][2 * jj].w * rs); o.z = pk2(v[rr][2 * jj + 1].x * rs, v[rr][2 * jj + 1].y * rs); o.w = pk2(v[rr][2 * jj + 1].z * rs, v[rr][2 * jj + 1].w * rs); o16[64 * jj] = o; } }
                else { u32x2* o8 = (u32x2*)(xb + (size_t)m * DM) + lane;
#pragma unroll
                    for (int j = 0; j < 4; ++j) { u32x2 o; o.x = pk2(v[rr][j].x * rs, v[rr][j].y * rs); o.y = pk2(v[rr][j].z * rs, v[rr][j].w * rs); o8[64 * j] = o; } } } } }
    }
}
template <int NTH>
__device__ __forceinline__ void prologue_weights(const Params& p, float* lds, int bid, int nblk) {
    constexpr int NTOT = DEPTH * TL_LAYER, RPI = NTH / 64; const int tid = threadIdx.x;
    const int gw_ = (bid * NTH + tid) >> 6, ngw_ = (nblk * NTH) >> 6, lane_ = tid & 63; int trip = 0; const int NTRIP = (T + 2 * ngw_ - 1) / (2 * ngw_);
#define PROLOGUE_ROW_TRIP() do { row_pass<0>(p.x, nullptr, nullptr, nullptr, nullptr, (bf16_t*)(p.ws + WS_XB), (float*)(p.ws + WS_RINV), gw_, ngw_, lane_, trip, 1); ++trip; } while (0)
    int it = bid; PTile cur{}; float v[8]; int rope_i = bid * NTH + tid;
    if (it < NTOT) { cur = ptile_desc(p, it); ptile_load<NTH>(cur, v); }
    while (it < NTOT) {
        const int itn = it + nblk; PTile nxt = cur; float vn[8];
        if (itn < NTOT) nxt = ptile_desc(p, itn);
        ptile_load<NTH>(nxt, vn);
        const int rp_i_ = rope_i; int rp_pos_ = 0; if (rp_i_ < T * 16) { rp_pos_ = p.pos[rp_i_ >> 4]; rope_i += nblk * NTH; }
        PROLOGUE_ROW_TRIP();
        if (rp_i_ < T * 16) prologue_rope_item(p, rp_i_, rp_pos_);
#pragma unroll
        for (int i = 0; i < 8; ++i) lds[(i * RPI + (tid >> 6)) * 65 + (tid & 63)] = v[i];
        __syncthreads();
        if (cur.kind == 0) ptile_store<0, NTH>(cur, lds); else if (cur.kind == 1) ptile_store<1, NTH>(cur, lds); else if (cur.kind == 2) ptile_store<2, NTH>(cur, lds); else ptile_store<3, NTH>(cur, lds);
        __syncthreads();
        cur = nxt; it = itn;
#pragma unroll
        for (int i = 0; i < 8; ++i) v[i] = vn[i];
    }
    for (; trip < NTRIP; ) PROLOGUE_ROW_TRIP();
    for (; rope_i < T * 16; rope_i += nblk * NTH) prologue_rope_item(p, rope_i, p.pos[rope_i >> 4]);
#undef PROLOGUE_ROW_TRIP
    const int gt = bid * NTH + threadIdx.x, ng = nblk * NTH;
    for (int l = 0; l < DEPTH; ++l) {
        unsigned* a = (unsigned*)((bf16_t*)(p.ws + WS_WIN) + (size_t)l * NP * DM + (size_t)DIN * DM);
        for (int i = gt; i < (NP - DIN) * DM / 2; i += ng) a[i] = 0u;
        unsigned* b = (unsigned*)((bf16_t*)(p.ws + WS_WUQ) + (size_t)l * 768 * 256 + (size_t)576 * 256);
        for (int i = gt; i < 192 * 256 / 2; i += ng) b[i] = 0u;
        unsigned* c = (unsigned*)((bf16_t*)(p.ws + WS_WUKV) + (size_t)l * 768 * 256);
        for (int i = gt; i < 768 * 64; i += ng) { const int row = i / 64, cw = i % 64; c[row * 128 + 64 + cw] = 0u; }
    }
}
template <int MODE>
__device__ __forceinline__ void row_pass_pf(const bf16_t* xbin, const bf16_t* y, const float* g, float* out, bf16_t* xb, float* rinv, int mbase, int gw, int ngw, int lane, int mend, int flip) {
    constexpr int R = 2;
    u32x4 nx[R][2], ny[R][2]; float nri[R];
#define RP_LOAD(M0) do { _Pragma("unroll") for (int rr = 0; rr < R; ++rr) { int m_ = (M0) + rr; m_ = m_ < mend ? m_ : mend - 1; m_ = flip >= 0 ? flip - m_ : m_;     \
        const u32x4* xr_ = (const u32x4*)(xbin + (size_t)m_ * DM) + lane; const u32x4* yr_ = (const u32x4*)(y + y_off((size_t)m_)) + lane; \
        nx[rr][0] = xr_[0]; nx[rr][1] = xr_[64]; ny[rr][0] = yr_[0]; ny[rr][1] = yr_[64]; nri[rr] = rinv[m_]; } } while (0)
#define RP_CVT(D, S) do { D[0] = (f32x4){__uint_as_float(S.x << 16), __uint_as_float(S.x & 0xffff0000u), __uint_as_float(S.y << 16), __uint_as_float(S.y & 0xffff0000u)}; \
        D[1] = (f32x4){__uint_as_float(S.z << 16), __uint_as_float(S.z & 0xffff0000u), __uint_as_float(S.w << 16), __uint_as_float(S.w & 0xffff0000u)}; } while (0)
    f32x4 gg[4];
#pragma unroll
    for (int j = 0; j < 4; ++j) gg[j] = ((const f32x4*)g)[(j >> 1) * 128 + lane * 2 + (j & 1)];
    RP_LOAD(mbase + gw * R);
    for (int m0 = mbase + gw * R; m0 < mend; m0 += R * ngw) {
        u32x4 cx[R][2], cy[R][2]; float ri[R];
#pragma unroll
        for (int rr = 0; rr < R; ++rr) { cx[rr][0] = nx[rr][0]; cx[rr][1] = nx[rr][1]; cy[rr][0] = ny[rr][0]; cy[rr][1] = ny[rr][1]; ri[rr] = nri[rr]; }
        RP_LOAD(m0 + R * ngw);
#pragma unroll
        for (int rr = 0; rr < R; ++rr) { const int ml_ = m0 + rr; const int m = flip >= 0 ? flip - ml_ : ml_; if (ml_ < mend) {
            f32x4 v[4], w[4]; RP_CVT((&v[0]), cx[rr][0]); RP_CVT((&v[2]), cx[rr][1]); RP_CVT((&w[0]), cy[rr][0]); RP_CVT((&w[2]), cy[rr][1]);
            float s = 0.f;
#pragma unroll
            for (int j = 0; j < 4; ++j) s += (w[j].x * w[j].x + w[j].y * w[j].y) + (w[j].z * w[j].z + w[j].w * w[j].w);
            const float rsy = 1.f / sqrtf(wave_sum(s) * (1.f / DM) + RMS_EPS);
#pragma unroll
            for (int j = 0; j < 4; ++j) { v[j] = v[j] * ri[rr] + w[j] * rsy * gg[j]; if (MODE == 2) ((f32x4*)(out + (size_t)m * DM))[(j >> 1) * 128 + lane * 2 + (j & 1)] = v[j]; }
            if (MODE == 1) { float s2 = 0.f;
#pragma unroll
                for (int j = 0; j < 4; ++j) s2 += (v[j].x * v[j].x + v[j].y * v[j].y) + (v[j].z * v[j].z + v[j].w * v[j].w);
                const float ms = sqrtf(wave_sum(s2) * (1.f / DM) + RMS_EPS), rs = 1.f / ms;
                if (lane == 0) rinv[m] = ms;
                u32x4* o16 = (u32x4*)(xb + (size_t)m * DM) + lane;
#pragma unroll
                for (int jj = 0; jj < 2; ++jj) { u32x4 o; o.x = pk2(v[2 * jj].x * rs, v[2 * jj].y * rs); o.y = pk2(v[2 * jj].z * rs, v[2 * jj].w * rs); o.z = pk2(v[2 * jj + 1].x * rs, v[2 * jj + 1].y * rs); o.w = pk2(v[2 * jj + 1].z * rs, v[2 * jj + 1].w * rs); o16[64 * jj] = o; } } } }
    }
#undef RP_LOAD
#undef RP_CVT
}
__device__ __forceinline__ void kr_rope_pass(const Params& p, int gt, int ng, int iend) {
    const bf16_t* proj = (const bf16_t*)(p.ws + WS_PROJ); bf16_t* kc = (bf16_t*)(p.ws + WS_KC); const float2* cs = (const float2*)(p.ws + WS_CS);
    constexpr int U = 4;
    for (int i0 = gt; i0 < iend; i0 += U * ng) {
        unsigned w[U]; float2 c[U];
#pragma unroll
        for (int k = 0; k < U; ++k) { const int i = i0 + k * ng; if (i < iend) { w[k] = *(const unsigned*)(proj + (size_t)(i >> 4) * NP + C_KR + 2 * (i & 15)); c[k] = cs[i]; } }
#pragma unroll
        for (int k = 0; k < U; ++k) { const int i = i0 + k * ng; if (i < iend) { const int t = i >> 4, f = i & 15;
            const float t1 = bf2f((bf16_t)(w[k] & 0xffffu)), t2 = bf2f((bf16_t)(w[k] >> 16));
            const unsigned o = pk2(t1 * c[k].x - t2 * c[k].y, t1 * c[k].y + t2 * c[k].x);
            *(unsigned*)((bf16_t*)(p.ws + WS_KR) + (size_t)t * 32 + 2 * f) = o; (void)kc; } }
    }
}

struct EpProj { bf16_t* O;
    __device__ __forceinline__ void apply8(int row, int col, const float* v) const {
        if (col >= DIN) return;
        u32x4 w; w.x = pk2(v[0], v[1]); w.y = pk2(v[2], v[3]); w.z = pk2(v[4], v[5]); w.w = pk2(v[6], v[7]); *(u32x4*)(O + (size_t)row * NP + col) = w; } };
struct EpQ { bf16_t* O; const float* part;
    __device__ __forceinline__ float rowscale(int row) const { const f32x4 pp = *(const f32x4*)(part + (size_t)row * 4); return 1.f / sqrtf(((pp.x + pp.y) + (pp.z + pp.w)) * (1.f / 256.f) + RMS_EPS); }
    __device__ __forceinline__ void apply8s(int row, int col, const float* v, float rs) const {
        if (col >= 576) return;
        u32x4 w; w.x = pk2(v[0] * rs, v[1] * rs); w.y = pk2(v[2] * rs, v[3] * rs); w.z = pk2(v[4] * rs, v[5] * rs); w.w = pk2(v[6] * rs, v[7] * rs); *(u32x4*)(O + (size_t)row * QC_LD + col) = w; } };
struct EpKV { bf16_t* Kc; bf16_t* Vc; const float* part;
    __device__ __forceinline__ float rowscale(int row) const { const f32x4 pp = *(const f32x4*)(part + (size_t)row * 4); return 1.f / sqrtf(((pp.x + pp.y) + (pp.z + pp.w)) * (1.f / 128.f) + RMS_EPS); }
    __device__ __forceinline__ void apply8s(int row, int col, const float* v, float rs) const {
        u32x4 w; w.x = pk2(v[0] * rs, v[1] * rs); w.y = pk2(v[2] * rs, v[3] * rs); w.z = pk2(v[4] * rs, v[5] * rs); w.w = pk2(v[6] * rs, v[7] * rs);
        if (col < 384) { const int h = col >> 6; *(u32x4*)(Kc + (size_t)row * KC_LD + h * 64 + (col & 63)) = w; }
        else *(u32x4*)(Vc + (size_t)row * VC_LD + (col - 384)) = w; } };
struct EpY { bf16_t* O;
    __device__ __forceinline__ void apply8(int row, int col, const float* v) const {
        u32x4 w; w.x = pk2(v[0], v[1]); w.y = pk2(v[2], v[3]); w.z = pk2(v[4], v[5]); w.w = pk2(v[6], v[7]); *(u32x4*)(O + y_off((size_t)row) + col) = w; } };
struct EpF32 { float* O;
    __device__ __forceinline__ void apply8(int row, int col, const float* v) const {
        f32x4* o = (f32x4*)(O + (size_t)row * DM + col); o[0] = (f32x4){v[0], v[1], v[2], v[3]}; o[1] = (f32x4){v[4], v[5], v[6], v[7]}; } };


namespace pg8 {
#define PG8_LAS __attribute__((address_space(3)))
typedef short bf16x8 __attribute__((ext_vector_type(8)));
constexpr int BM = 256, BK = 64, HALF = 128, HTB = HALF * BK * 2  , STAGE_BYTES = 8 * HTB, NXCD = 8, WGM = 4;
__host__ __device__ __forceinline__ int lds_byte(int r, int c) { const int st = (r >> 4) * 2 + (c >> 5), rr = r & 15, cc = c & 31, ob = rr * 64 + cc * 2; return st * 1024 + (ob ^ (((ob >> 9) & 1) << 5)); }
__host__ __device__ __forceinline__ void stage_rc(int b, int& R, int& C) { const int st = b / 1024, sb = b % 1024, swz = sb ^ (((sb >> 9) & 1) << 5); R = (st >> 1) * 16 + swz / 64; C = (st & 1) * 32 + (swz % 64) / 2; }
__host__ __device__ __forceinline__ int perm32(int rho) { const int n = rho >> 4, i = rho & 15; return 8 * (i >> 2) + 4 * n + (i & 3); }
struct Unit { int pm, pn; };
struct Gemm { const bf16_t* A; const bf16_t* Bt; int lda, ldb, K; };
struct StaticOrder {
    int nM, nN, nwg, G, c, wgm;
    __host__ __device__ void init(int M, int N, int G_, int c_, int wgm_ = WGM) { nM = M / BM; nN = N / BM; nwg = nM * nN; G = G_; c = c_; wgm = wgm_; }
    __host__ __device__ bool next(int i, Unit& u) const {
        const long L = (long)i * G + c; if (L >= nwg) return false;
        int wgid = (int)L; { const int q = nwg / NXCD, r = nwg % NXCD, xcd = wgid % NXCD, off = wgid / NXCD; wgid = (xcd < r ? xcd * (q + 1) : r * (q + 1) + (xcd - r) * q) + off; }
        const int nig = wgm * nN, gid = wgid / nig, fm = gid * wgm, gsz = (nM - fm) < wgm ? (nM - fm) : wgm;
        u.pm = fm + ((wgid % nig) % gsz); u.pn = (wgid % nig) / gsz; return true;
    }
    __device__ __forceinline__ void a_ready(const Unit&) const {}
    __device__ __forceinline__ void done(const Unit&) const {}
};
struct RangeOrder {
    int lo, cnt, nN, G, c, i0, pm0 = 0;
    __device__ void init(int lo_, int cnt_, int nN_, int G_, int c_) { lo = lo_; cnt = cnt_; nN = nN_; G = G_; c = c_; i0 = (c >= lo) ? 0 : (lo - c + G - 1) / G; }
    __device__ bool next(int i, Unit& u) const { const int Lg = (i0 + i) * G + c - lo; if (Lg >= cnt) return false; u.pm = pm0 + Lg / nN; u.pn = Lg % nN; return true; }
    __device__ __forceinline__ void a_ready(const Unit&) const {}
    __device__ __forceinline__ void done(const Unit&) const {}
};
template <class E8, bool SSQ, bool ROWSCALE = false> struct EpiWrap {
    static constexpr bool PERM = true, AFTER_DRAIN = false;
    E8 e; float* partq; float* partkv;
    __device__ __forceinline__ void operator()(const f32x4 (&acc)[2][2][4][2], const Unit& u, int wr, int wc, int fr, int fq) const {
        const int row0 = u.pm * BM + wr * 64 + fr, col0 = u.pn * BM + wc * 32 + 8 * fq;
        float rsc[2][4];
        if constexpr (ROWSCALE) {
#pragma unroll
            for (int ai = 0; ai < 2; ++ai)
#pragma unroll
                for (int m = 0; m < 4; ++m) rsc[ai][m] = e.rowscale(row0 + ai * HALF + m * 16); }
#pragma unroll
        for (int ai = 0; ai < 2; ++ai)
#pragma unroll
            for (int m = 0; m < 4; ++m) { const int row = row0 + ai * HALF + m * 16;
#pragma unroll
                for (int bj = 0; bj < 2; ++bj) { const f32x4 a = acc[ai][bj][m][0], b = acc[ai][bj][m][1]; const float v[8] = {a[0], a[1], a[2], a[3], b[0], b[1], b[2], b[3]};
                    if constexpr (ROWSCALE) e.apply8s(row, col0 + bj * HALF, v, rsc[ai][m]); else e.apply8(row, col0 + bj * HALF, v); }
                }
        if (SSQ && (u.pn == C_CQ / 256 || u.pn == C_CKV / 256)) { const bool isq = (u.pn == C_CQ / 256); float* part = isq ? partq : partkv;
#pragma unroll
            for (int ai = 0; ai < 2; ++ai)
#pragma unroll
                for (int m = 0; m < 4; ++m) { float s = 0.f;
#pragma unroll
                    for (int n = 0; n < 2; ++n) { const f32x4 a = acc[ai][0][m][n]; s += (a[0] * a[0] + a[1] * a[1]) + (a[2] * a[2] + a[3] * a[3]); }
                    if (isq) {
#pragma unroll
                        for (int n = 0; n < 2; ++n) { const f32x4 a = acc[ai][1][m][n]; s += (a[0] * a[0] + a[1] * a[1]) + (a[2] * a[2] + a[3] * a[3]); } }
                    s += __shfl_xor(s, 16); s += __shfl_xor(s, 32);
                    if (fq == 0) part[(size_t)(row0 + ai * HALF + m * 16) * 4 + wc] = s; } }
    }
};
template <class Epi, class Sched, bool ALIGN_EPI = false, bool SP2 = false>
__device__ __forceinline__ void gemm_phase(PG8_LAS unsigned char* lds, const Gemm g, const Sched& S, const Epi& E) {
    const int tid = tid_opaque(), wid = __builtin_amdgcn_readfirstlane(tid >> 6), lane = tid & 63, wr = wid >> 2, wc = wid & 3, fr = lane & 15, fq = lane >> 4;
    const int K = g.K, nt = K / BK, lda = g.lda, ldb = g.ldb;
    unsigned voffA[2], voffB[2];
#pragma unroll
    for (int i = 0; i < 2; ++i) { int R, C; stage_rc(tid * 16 + i * 8192, R, C); const int Rb = Epi::PERM ? ((R & ~31) + perm32(R & 31)) : R;
        voffA[i] = (unsigned)(R * lda + C) * 2u; voffB[i] = (unsigned)(Rb * ldb + C) * 2u; }
    const size_t kstep = (size_t)(BK * 2);
    const size_t hsA = (size_t)HALF * lda * 2, hsB = (size_t)HALF * ldb * 2;
    const size_t tsA = 2 * hsA, tsB = 2 * hsB;
    const unsigned ldsw = (unsigned)wid * 1024u;
    const int aoff = lds_byte(wr * 64 + fr, fq * 8), boff = lds_byte(wc * 32 + fr, fq * 8);
#define PG8_SA(b, h) (((b) * 2 + (h)) * HTB)
#define PG8_SB(b, h) ((4 + (b) * 2 + (h)) * HTB)
#define PG8_STAGE(bufoff, gbase, voff) do { _Pragma("unroll") for (int _i = 0; _i < 2; ++_i) \
        __builtin_amdgcn_global_load_lds((const unsigned*)((const char*)(gbase) + (voff)[_i]), (PG8_LAS unsigned*)(lds + (bufoff) + ldsw + _i * 8192), 16, 0, 0); } while (0)
#define PG8_LDA(dst, b, h) do { _Pragma("unroll") for (int m = 0; m < 4; ++m) _Pragma("unroll") for (int k = 0; k < 2; ++k) dst[m][k] = *(const PG8_LAS bf16x8*)(lds + PG8_SA(b, h) + aoff + m * 2048 + k * 1024); } while (0)
#define PG8_LDB(dst, b, h) do { _Pragma("unroll") for (int n = 0; n < 2; ++n) _Pragma("unroll") for (int k = 0; k < 2; ++k) dst[n][k] = *(const PG8_LAS bf16x8*)(lds + PG8_SB(b, h) + boff + n * 2048 + k * 1024); } while (0)
#define PG8_MMA(ai, bj, At, Bt) do { __builtin_amdgcn_s_setprio(1); _Pragma("unroll") for (int m = 0; m < 4; ++m) _Pragma("unroll") for (int n = 0; n < 2; ++n) _Pragma("unroll") for (int k = 0; k < 2; ++k) \
        acc[ai][bj][m][n] = __builtin_amdgcn_mfma_f32_16x16x32_bf16(Bt[n][k], At[m][k], acc[ai][bj][m][n], 0, 0, 0); __builtin_amdgcn_s_setprio(0); } while (0)
#define PG8_WAIT_V(n) asm volatile("s_waitcnt vmcnt(" #n ")" ::: "memory")
#define PG8_WAIT_L(n) asm volatile("s_waitcnt lgkmcnt(" #n ")" ::: "memory")
#define PG8_BAR __builtin_amdgcn_s_barrier()
#define PG8_SCHED __builtin_amdgcn_sched_barrier(0)
    Unit cur, nxt; int ui = 0;
    if (!S.next(0, cur)) return;
    f32x4 acc[2][2][4][2];
#pragma unroll
    for (int a = 0; a < 2; ++a)
#pragma unroll
        for (int b = 0; b < 2; ++b)
#pragma unroll
            for (int m = 0; m < 4; ++m)
#pragma unroll
                for (int n = 0; n < 2; ++n) acc[a][b][m][n] = (f32x4){0.f, 0.f, 0.f, 0.f};
    bf16x8 At[4][2], B0[2][2], B1[2][2];
    const char* cA = (const char*)g.A + (size_t)cur.pm * tsA; const char* cB = (const char*)g.Bt + (size_t)cur.pn * tsB;
    S.a_ready(cur);
    if constexpr (SP2) {
        PG8_STAGE(PG8_SB(0, 0), cB, voffB); PG8_STAGE(PG8_SB(0, 1), cB + hsB, voffB); PG8_STAGE(PG8_SA(0, 0), cA, voffA); PG8_STAGE(PG8_SA(0, 1), cA + hsA, voffA);
        if (wr == 1) PG8_BAR;
        PG8_WAIT_V(2); PG8_BAR;
        PG8_STAGE(PG8_SB(1, 0), cB + kstep, voffB); PG8_STAGE(PG8_SA(1, 0), cA + kstep, voffA); PG8_STAGE(PG8_SB(1, 1), cB + hsB + kstep, voffB);
        PG8_WAIT_V(6); PG8_BAR;
    } else {
        PG8_STAGE(PG8_SB(0, 0), cB, voffB); PG8_STAGE(PG8_SA(0, 0), cA, voffA); PG8_STAGE(PG8_SB(0, 1), cB + hsB, voffB); PG8_STAGE(PG8_SA(0, 1), cA + hsA, voffA);
        if (wr == 1) PG8_BAR;
        PG8_WAIT_V(4); PG8_BAR;
        PG8_STAGE(PG8_SB(1, 0), cB + kstep, voffB); PG8_STAGE(PG8_SA(1, 0), cA + kstep, voffA); PG8_STAGE(PG8_SB(1, 1), cB + hsB + kstep, voffB);
        PG8_WAIT_V(6); PG8_BAR;
    }
    for (;;) {
        const bool has_next = S.next(ui + 1, nxt);
        const char* nA = has_next ? (const char*)g.A + (size_t)nxt.pm * tsA : cA; const char* nB = has_next ? (const char*)g.Bt + (size_t)nxt.pn * tsB : cB;
#pragma unroll 1
        for (int t = 0; t < nt; t += 2) {
            const bool last = (t == nt - 2);
            const char* a1 = cA + (size_t)(t + 1) * kstep;
            const char* a2 = last ? nA : cA + (size_t)(t + 2) * kstep; const char* b2 = last ? nB : cB + (size_t)(t + 2) * kstep;
            const char* a3 = a2 + kstep; const char* b3 = b2 + kstep;
            if (last && has_next) S.a_ready(nxt);
            if constexpr (SP2) {
            PG8_LDB(B0, 0, 0); PG8_LDB(B1, 0, 1); PG8_SCHED; PG8_LDA(At, 0, 0); PG8_STAGE(PG8_SA(1, 1), a1 + hsA, voffA);
            PG8_WAIT_V(8); PG8_WAIT_L(0); PG8_BAR; PG8_MMA(0, 0, At, B0); PG8_MMA(0, 1, At, B1); PG8_BAR; PG8_SCHED;
            PG8_LDA(At, 0, 1); PG8_STAGE(PG8_SB(0, 0), b2, voffB); PG8_STAGE(PG8_SB(0, 1), b2 + hsB, voffB); PG8_STAGE(PG8_SA(0, 0), a2, voffA);
            PG8_WAIT_V(8); PG8_WAIT_L(0); PG8_BAR; PG8_MMA(1, 0, At, B0); PG8_MMA(1, 1, At, B1); PG8_BAR; PG8_SCHED;
            PG8_LDB(B0, 1, 0); PG8_LDB(B1, 1, 1); PG8_SCHED; PG8_LDA(At, 1, 0); PG8_STAGE(PG8_SA(0, 1), a2 + hsA, voffA);
            PG8_WAIT_V(8); PG8_WAIT_L(0); PG8_BAR; PG8_MMA(0, 0, At, B0); PG8_MMA(0, 1, At, B1); PG8_BAR; PG8_SCHED;
            PG8_LDA(At, 1, 1); PG8_STAGE(PG8_SB(1, 0), b3, voffB); PG8_STAGE(PG8_SB(1, 1), b3 + hsB, voffB); PG8_STAGE(PG8_SA(1, 0), a3, voffA);
            PG8_WAIT_V(8); PG8_WAIT_L(0); PG8_BAR; PG8_MMA(1, 0, At, B0); PG8_MMA(1, 1, At, B1); PG8_BAR; PG8_SCHED;
            } else {
            PG8_LDB(B0, 0, 0); PG8_SCHED; PG8_LDA(At, 0, 0); PG8_STAGE(PG8_SA(1, 1), a1 + hsA, voffA);
            PG8_WAIT_L(8); PG8_BAR; PG8_WAIT_L(0); PG8_MMA(0, 0, At, B0); PG8_BAR; PG8_SCHED;
            PG8_LDB(B1, 0, 1); PG8_STAGE(PG8_SB(0, 0), b2, voffB);
            PG8_BAR; PG8_WAIT_L(0); PG8_MMA(0, 1, At, B1); PG8_BAR;
            PG8_LDA(At, 0, 1); PG8_STAGE(PG8_SA(0, 0), a2, voffA);
            PG8_BAR; PG8_WAIT_L(0); PG8_MMA(1, 0, At, B0); PG8_BAR; PG8_SCHED;
            PG8_STAGE(PG8_SB(0, 1), b2 + hsB, voffB);
            PG8_WAIT_V(6); PG8_BAR; PG8_MMA(1, 1, At, B1); PG8_BAR;
            PG8_LDB(B0, 1, 0); PG8_SCHED; PG8_LDA(At, 1, 0); PG8_STAGE(PG8_SA(0, 1), a2 + hsA, voffA);
            PG8_WAIT_L(8); PG8_BAR; PG8_WAIT_L(0); PG8_MMA(0, 0, At, B0); PG8_BAR; PG8_SCHED;
            PG8_LDB(B1, 1, 1); PG8_STAGE(PG8_SB(1, 0), b3, voffB);
            PG8_BAR; PG8_WAIT_L(0); PG8_MMA(0, 1, At, B1); PG8_BAR;
            PG8_LDA(At, 1, 1); PG8_STAGE(PG8_SA(1, 0), a3, voffA);
            PG8_BAR; PG8_WAIT_L(0); PG8_MMA(1, 0, At, B0); PG8_BAR; PG8_SCHED;
            PG8_STAGE(PG8_SB(1, 1), b3 + hsB, voffB);
            PG8_WAIT_V(6); PG8_BAR; PG8_MMA(1, 1, At, B1); PG8_BAR;
            }
        }
        if constexpr (ALIGN_EPI) { if (wr == 0) PG8_BAR; }
        if constexpr (!Epi::AFTER_DRAIN) { E(acc, cur, wr, wc, fr, fq); S.done(cur); }
        if (!has_next) break;
#pragma unroll
        for (int a = 0; a < 2; ++a)
#pragma unroll
            for (int b = 0; b < 2; ++b)
#pragma unroll
                for (int m = 0; m < 4; ++m)
#pragma unroll
                    for (int n = 0; n < 2; ++n) acc[a][b][m][n] = (f32x4){0.f, 0.f, 0.f, 0.f};
        cur = nxt; cA = nA; cB = nB; ++ui;
        if constexpr (ALIGN_EPI) { if (wr == 1) PG8_BAR; }
    }
    PG8_WAIT_V(0);
    if constexpr (!ALIGN_EPI) { if (wr == 0) PG8_BAR; }
    PG8_BAR;
    if constexpr (Epi::AFTER_DRAIN) { E.fused(acc, cur, wr, wc, fr, fq, lds, wid, lane); S.done(cur); }
#undef PG8_SA
#undef PG8_SB
#undef PG8_STAGE
#undef PG8_LDA
#undef PG8_LDB
#undef PG8_MMA
#undef PG8_WAIT_V
#undef PG8_WAIT_L
#undef PG8_BAR
#undef PG8_SCHED
}
}

namespace att {
typedef short bf16x8 __attribute__((ext_vector_type(8)));
typedef short s16x4 __attribute__((ext_vector_type(4)));
typedef float f32x16 __attribute__((ext_vector_type(16)));
#define ALAS __attribute__((address_space(3)))
#define SBAR() __builtin_amdgcn_sched_barrier(0)
constexpr float THR2 = 11.5f;
constexpr int KP64 = 144, KP96 = 208, VTB = 8192;
__device__ __forceinline__ int crow(int r, int hi) { return (r & 3) + 8 * (r >> 2) + 4 * hi; }
__device__ __forceinline__ unsigned cvtpk(float lo, float hi) { unsigned r; asm volatile("v_cvt_pk_bf16_f32 %0, %1, %2" : "=v"(r) : "v"(lo), "v"(hi)); return r; }
__device__ __forceinline__ int v_st(int k, int c) { const int kk = (k & ~0xC) | ((k & 4) << 1) | ((k & 8) >> 1); return ((kk >> 3) * 2 + (c >> 5)) * 512 + ((kk & 7) * 32 + (c & 31)) * 2; }
__device__ __forceinline__ int v_rd_base(int lane) { return ((lane & 3) << 3) | (((lane >> 2) & 3) << 6) | (((lane >> 4) & 1) << 5) | (((lane >> 5) & 1) << 8); }
constexpr int v_rd_off(int d0, int ks, int half) { return d0 * 512 + ks * 2048 + half * 1024; }
typedef short v4i16_t __attribute__((ext_vector_type(4)));
template <int OFF> __device__ __forceinline__ s16x4 tr_read(int vb) {
    return __builtin_bit_cast(s16x4, __builtin_amdgcn_ds_read_tr16_b64_v4i16((ALAS v4i16_t*)(uintptr_t)(unsigned)(vb + OFF))); }
template <int D0> __device__ __forceinline__ void pv_one(f32x16& od, int vb, bf16x8 pa0, bf16x8 pa1, bf16x8 pa2, bf16x8 pa3) {
    const s16x4 l0 = tr_read<v_rd_off(D0, 0, 0)>(vb), h0 = tr_read<v_rd_off(D0, 0, 1)>(vb), l1 = tr_read<v_rd_off(D0, 1, 0)>(vb), h1 = tr_read<v_rd_off(D0, 1, 1)>(vb);
    const s16x4 l2 = tr_read<v_rd_off(D0, 2, 0)>(vb), h2 = tr_read<v_rd_off(D0, 2, 1)>(vb), l3 = tr_read<v_rd_off(D0, 3, 0)>(vb), h3 = tr_read<v_rd_off(D0, 3, 1)>(vb);
#define ATT_PK(L, H) (bf16x8){L[0], L[1], L[2], L[3], H[0], H[1], H[2], H[3]}
    od = __builtin_amdgcn_mfma_f32_32x32x16_bf16(pa0, ATT_PK(l0, h0), od, 0, 0, 0);
    od = __builtin_amdgcn_mfma_f32_32x32x16_bf16(pa1, ATT_PK(l1, h1), od, 0, 0, 0);
    od = __builtin_amdgcn_mfma_f32_32x32x16_bf16(pa2, ATT_PK(l2, h2), od, 0, 0, 0);
    od = __builtin_amdgcn_mfma_f32_32x32x16_bf16(pa3, ATT_PK(l3, h3), od, 0, 0, 0);
#undef ATT_PK
}
__device__ __forceinline__ void pv2(f32x16* o, int vb, bf16x8 pa0, bf16x8 pa1, bf16x8 pa2, bf16x8 pa3) { pv_one<0>(o[0], vb, pa0, pa1, pa2, pa3); pv_one<1>(o[1], vb, pa0, pa1, pa2, pa3); }
template <int NK, int PITCH> __device__ __forceinline__ void qkt(f32x16& p0, f32x16& p1, const ALAS unsigned char* Ks, const bf16x8* qr, int r32, int hi) {
    p0 = f32x16{}; p1 = f32x16{};
#pragma unroll
    for (int d0 = 0; d0 < NK; ++d0) { const int cb = (d0 * 16 + hi * 8) * 2;
        const bf16x8 b0 = *(const ALAS bf16x8*)(Ks + r32 * PITCH + cb);
        const bf16x8 b1 = *(const ALAS bf16x8*)(Ks + (32 + r32) * PITCH + cb);
        p0 = __builtin_amdgcn_mfma_f32_32x32x16_bf16(b0, qr[d0], p0, 0, 0, 0);
        p1 = __builtin_amdgcn_mfma_f32_32x32x16_bf16(b1, qr[d0], p1, 0, 0, 0); }
}
__device__ __forceinline__ void partialSM(f32x16& p0, f32x16& p1, float& m_reg, float& alpha) {
    float pmax = p0[0];
#pragma unroll
    for (int r = 1; r < 16; ++r) pmax = fmaxf(pmax, p0[r]);
#pragma unroll
    for (int r = 0; r < 16; ++r) pmax = fmaxf(pmax, p1[r]);
    { auto rr = __builtin_amdgcn_permlane32_swap(__float_as_uint(pmax), __float_as_uint(pmax), false, false); pmax = fmaxf(__uint_as_float(rr[0]), __uint_as_float(rr[1])); }
    float mn;
    if (__builtin_expect(__all(pmax - m_reg <= THR2), 1)) { mn = m_reg; alpha = 1.f; }
    else { mn = fmaxf(m_reg, pmax); alpha = __builtin_amdgcn_exp2f(m_reg - mn); m_reg = mn; }
#pragma unroll
    for (int r = 0; r < 16; ++r) { p0[r] -= mn; p1[r] -= mn; }
#pragma unroll
    for (int r = 0; r < 16; ++r) p0[r] = __builtin_amdgcn_exp2f(p0[r]);
}
template <int NK, int PITCH> __device__ __forceinline__ void qkt_neg(f32x16& p0, f32x16& p1, const ALAS unsigned char* Ks, const bf16x8* qr, const f32x16& negm, int r32, int hi) {
#pragma unroll
    for (int d0 = 0; d0 < NK; ++d0) { const int cb = (d0 * 16 + hi * 8) * 2;
        const bf16x8 b0 = *(const ALAS bf16x8*)(Ks + r32 * PITCH + cb);
        const bf16x8 b1 = *(const ALAS bf16x8*)(Ks + (32 + r32) * PITCH + cb);
        if (d0 == 0) { p0 = __builtin_amdgcn_mfma_f32_32x32x16_bf16(b0, qr[0], negm, 0, 0, 0); p1 = __builtin_amdgcn_mfma_f32_32x32x16_bf16(b1, qr[0], negm, 0, 0, 0); }
        else { p0 = __builtin_amdgcn_mfma_f32_32x32x16_bf16(b0, qr[d0], p0, 0, 0, 0); p1 = __builtin_amdgcn_mfma_f32_32x32x16_bf16(b1, qr[d0], p1, 0, 0, 0); } }
}
__device__ __forceinline__ float rowmax32(const f32x16& p0, const f32x16& p1) {
    float pmax = p0[0];
#pragma unroll
    for (int r = 1; r < 16; ++r) pmax = fmaxf(pmax, p0[r]);
#pragma unroll
    for (int r = 0; r < 16; ++r) pmax = fmaxf(pmax, p1[r]);
    auto rr = __builtin_amdgcn_permlane32_swap(__float_as_uint(pmax), __float_as_uint(pmax), false, false); return fmaxf(__uint_as_float(rr[0]), __uint_as_float(rr[1]));
}
__device__ __forceinline__ void partialSM_first(f32x16& p0, f32x16& p1, float& m_reg, f32x16& negm, float& alpha) {
    const float pmax = rowmax32(p0, p1); m_reg = pmax; alpha = 0.f;
#pragma unroll
    for (int r = 0; r < 16; ++r) { p0[r] -= pmax; p1[r] -= pmax; negm[r] = -pmax; }
    asm volatile("" : "+v"(negm));
#pragma unroll
    for (int r = 0; r < 16; ++r) p0[r] = __builtin_amdgcn_exp2f(p0[r]);
}
__device__ __forceinline__ void partialSM_rel(f32x16& p0, f32x16& p1, float& m_reg, f32x16& negm, float& alpha) {
    const float pmax = rowmax32(p0, p1);
    if (__builtin_expect(__all(pmax <= THR2), 1)) { alpha = 1.f; }
    else { const float dl = fmaxf(pmax, 0.f); m_reg += dl; alpha = __builtin_amdgcn_exp2f(-dl);
#pragma unroll
        for (int r = 0; r < 16; ++r) { p0[r] -= dl; p1[r] -= dl; negm[r] = -m_reg; }
        asm volatile("" : "+v"(negm)); }
#pragma unroll
    for (int r = 0; r < 16; ++r) p0[r] = __builtin_amdgcn_exp2f(p0[r]);
}
__device__ __forceinline__ void finishSM(f32x16& p0, f32x16& p1, float alpha, float& l_reg, bf16x8& pa0, bf16x8& pa1, bf16x8& pa2, bf16x8& pa3) {
#pragma unroll
    for (int r = 0; r < 16; ++r) p1[r] = __builtin_amdgcn_exp2f(p1[r]);
    float ps = 0.f;
#pragma unroll
    for (int r = 0; r < 16; ++r) ps += p0[r];
#pragma unroll
    for (int r = 0; r < 16; ++r) ps += p1[r];
    { auto rr = __builtin_amdgcn_permlane32_swap(__float_as_uint(ps), __float_as_uint(ps), false, false); ps = __uint_as_float(rr[0]) + __uint_as_float(rr[1]); }
    l_reg = l_reg * alpha + ps;
#define ATT_PK4(P, BASE, OUT) do { unsigned a0 = cvtpk(P[BASE + 0], P[BASE + 1]), a1 = cvtpk(P[BASE + 2], P[BASE + 3]); \
    unsigned b0 = cvtpk(P[BASE + 4], P[BASE + 5]), b1 = cvtpk(P[BASE + 6], P[BASE + 7]); \
    auto r0 = __builtin_amdgcn_permlane32_swap(a0, b0, false, false); auto r1 = __builtin_amdgcn_permlane32_swap(a1, b1, false, false); \
    u32x4 w = {r0[0], r1[0], r0[1], r1[1]}; OUT = __builtin_bit_cast(bf16x8, w); } while (0)
    ATT_PK4(p0, 0, pa0); ATT_PK4(p0, 8, pa1); ATT_PK4(p1, 0, pa2); ATT_PK4(p1, 8, pa3);
#undef ATT_PK4
}
#define ATT_RESC(a, al_l) do { if (__any((a) < 1.f)) { if (hi == 0) (al_l)[r32] = (a); asm volatile("s_waitcnt lgkmcnt(0)" ::: "memory"); \
    _Pragma("unroll") for (int d_ = 0; d_ < 2; ++d_) _Pragma("unroll") for (int r_ = 0; r_ < 16; ++r_) o[d_][r_] *= (al_l)[crow(r_, hi)]; } } while (0)
__device__ __forceinline__ void unpack8(const u32x4 w, float* f) {
#pragma unroll
    for (int j = 0; j < 4; ++j) { f[2 * j] = __uint_as_float(w[j] << 16); f[2 * j + 1] = __uint_as_float(w[j] & 0xffff0000u); }
}
__device__ __forceinline__ u32x4 pack8(const float* f) { u32x4 w; w.x = pk2(f[0], f[1]); w.y = pk2(f[2], f[3]); w.z = pk2(f[4], f[5]); w.w = pk2(f[6], f[7]); return w; }

__device__ __forceinline__ int cv_st(int k, int sc) { return (sc >> 2) * 4096 + k * 64 + (sc & 3) * 16; }
__device__ __forceinline__ int cv_rd_base(int lane) { return ((lane >> 4) & 1) * 32 + (lane & 3) * 8 + (4 * (lane >> 5) + ((lane & 15) >> 2)) * 64; }
__device__ __forceinline__ bf16x8 c_frag_rt(int vb, int d0, int ks) { const s16x4 l = tr_read<0>(vb + d0 * 4096 + ks * 1024), h = tr_read<512>(vb + d0 * 4096 + ks * 1024); return (bf16x8){l[0], l[1], l[2], l[3], h[0], h[1], h[2], h[3]}; }
__device__ __forceinline__ void finishSM_pack(f32x16& p0, f32x16& p1, float alpha, float& l_reg, bf16x8 (&pa)[4]) {
#pragma unroll
    for (int r = 0; r < 16; ++r) p1[r] = __builtin_amdgcn_exp2f(p1[r]);
    float ps = 0.f;
#pragma unroll
    for (int r = 0; r < 16; ++r) ps += p0[r];
#pragma unroll
    for (int r = 0; r < 16; ++r) ps += p1[r];
    { auto rr = __builtin_amdgcn_permlane32_swap(__float_as_uint(ps), __float_as_uint(ps), false, false); ps = __uint_as_float(rr[0]) + __uint_as_float(rr[1]); }
    l_reg = l_reg * alpha + ps;
    { u32x4 w = {cvtpk(p0[0], p0[1]), cvtpk(p0[2], p0[3]), cvtpk(p0[4], p0[5]), cvtpk(p0[6], p0[7])}; pa[0] = __builtin_bit_cast(bf16x8, w); }
    { u32x4 w = {cvtpk(p0[8], p0[9]), cvtpk(p0[10], p0[11]), cvtpk(p0[12], p0[13]), cvtpk(p0[14], p0[15])}; pa[1] = __builtin_bit_cast(bf16x8, w); }
    { u32x4 w = {cvtpk(p1[0], p1[1]), cvtpk(p1[2], p1[3]), cvtpk(p1[4], p1[5]), cvtpk(p1[6], p1[7])}; pa[2] = __builtin_bit_cast(bf16x8, w); }
    { u32x4 w = {cvtpk(p1[8], p1[9]), cvtpk(p1[10], p1[11]), cvtpk(p1[12], p1[13]), cvtpk(p1[14], p1[15])}; pa[3] = __builtin_bit_cast(bf16x8, w); }
}
template <int I> __device__ __forceinline__ bf16x8 c_frag(int vb, const ALAS unsigned char* Kb) {
    if constexpr (I < 8) { constexpr int d0 = I & 1, ks = I >> 1; const s16x4 l = tr_read<d0 * 4096 + ks * 1024>(vb), h = tr_read<d0 * 4096 + ks * 1024 + 512>(vb); return (bf16x8){l[0], l[1], l[2], l[3], h[0], h[1], h[2], h[3]}; }
    else { constexpr int d0 = (I - 8) >> 1, half = (I - 8) & 1; return *(const ALAS bf16x8*)(Kb + half * 32 * KP96 + d0 * 32); }
}
template <int I> struct CMSeg {
    static __device__ __forceinline__ void run(f32x16* o, f32x16& p0, f32x16& p1, bf16x8 (&F)[4], const bf16x8 (&pa)[4], const bf16x8* qr, const f32x16& negm, int vb, const ALAS unsigned char* Kb) {
        if constexpr (I < 8) { o[I & 1] = __builtin_amdgcn_mfma_f32_32x32x16_bf16(pa[I >> 1], F[I & 3], o[I & 1], 0, 0, 0); }
        else { constexpr int d0 = (I - 8) >> 1, half = (I - 8) & 1;
            if constexpr (half == 0) { if constexpr (d0 == 0) p0 = __builtin_amdgcn_mfma_f32_32x32x16_bf16(F[I & 3], qr[0], negm, 0, 0, 0); else p0 = __builtin_amdgcn_mfma_f32_32x32x16_bf16(F[I & 3], qr[d0], p0, 0, 0, 0); }
            else { if constexpr (d0 == 0) p1 = __builtin_amdgcn_mfma_f32_32x32x16_bf16(F[I & 3], qr[0], negm, 0, 0, 0); else p1 = __builtin_amdgcn_mfma_f32_32x32x16_bf16(F[I & 3], qr[d0], p1, 0, 0, 0); } }
        if constexpr (I + 4 < 20) F[I & 3] = c_frag<I + 4>(vb, Kb);
        SBAR();
        if constexpr (I + 1 < 20) CMSeg<I + 1>::run(o, p0, p1, F, pa, qr, negm, vb, Kb);
    }
};
__device__ __forceinline__ void c_mseg(f32x16* o, f32x16& p0, f32x16& p1, const bf16x8 (&pa)[4], const bf16x8* qr, const f32x16& negm, int vb, const ALAS unsigned char* Kb) {
    bf16x8 F[4]; SBAR();
    F[0] = c_frag<0>(vb, Kb); F[1] = c_frag<1>(vb, Kb); F[2] = c_frag<2>(vb, Kb); F[3] = c_frag<3>(vb, Kb); SBAR();
    CMSeg<0>::run(o, p0, p1, F, pa, qr, negm, vb, Kb);
}

constexpr int C2_KB = 128 * KP96, C2_VB = 2 * VTB, C_LDS_K = 0, C_LDS_V = 2 * C2_KB, C_LDS_WS = C_LDS_V + 3 * C2_VB, C_LDS_STG = C_LDS_WS + 8 * 256, C_LDS_END = C_LDS_STG + 8 * 4096;
template <int F> __device__ __forceinline__ bf16x8 c2_frag(int vb, const ALAS unsigned char* Kb) {
    if constexpr (F < 16) { constexpr int sub = F >> 3, f = F & 7, d0 = f & 1, ks = f >> 1; const s16x4 l = tr_read<sub * VTB + d0 * 4096 + ks * 1024>(vb), h = tr_read<sub * VTB + d0 * 4096 + ks * 1024 + 512>(vb);
        return (bf16x8){l[0], l[1], l[2], l[3], h[0], h[1], h[2], h[3]}; }
    else { constexpr int f = F - 16, sub = f / 12, g = f % 12, d0 = g >> 1, half = g & 1; return *(const ALAS bf16x8*)(Kb + (sub * 64 + half * 32) * KP96 + d0 * 32); }
}
struct C2NoStage { template <int I> __device__ __forceinline__ void at() {} };
struct C2Stage { bf16x8 &skA, &skB, &skR, &svA, &svB; ALAS unsigned char* kd; ALAS unsigned char* kd2; ALAS unsigned char* vd; const bf16_t* ks; const bf16_t* ks2; const bf16_t* vs;
    template <int I> __device__ __forceinline__ void at() {
        if constexpr (I == 1) *(ALAS bf16x8*)(kd) = skA;
        if constexpr (I == 3) *(ALAS bf16x8*)(kd + 64 * KP96) = skB;
        if constexpr (I == 5) *(ALAS bf16x8*)(kd2) = skR;
        if constexpr (I == 7) *(ALAS bf16x8*)(vd) = svA;
        if constexpr (I == 9) *(ALAS bf16x8*)(vd + VTB) = svB;
        if constexpr (I == 13) skA = *(const bf16x8*)(ks);
        if constexpr (I == 16) skB = *(const bf16x8*)(ks + (size_t)64 * KC_LD);
        if constexpr (I == 19) skR = *(const bf16x8*)(ks2);
        if constexpr (I == 22) svA = *(const bf16x8*)(vs);
        if constexpr (I == 25) svB = *(const bf16x8*)(vs + (size_t)64 * VC_LD);
    } };
template <int I> struct C2MSeg {
    template <class ST> static __device__ __forceinline__ void run(f32x16* o, f32x16 (&p)[4], bf16x8 (&F)[4], const bf16x8 (&pa)[8], const bf16x8* qr, const f32x16& negm, int vb, const ALAS unsigned char* Kb, ST& st) {
        if constexpr (I < 16) { constexpr int sub = I >> 3, f = I & 7; o[f & 1] = __builtin_amdgcn_mfma_f32_32x32x16_bf16(pa[sub * 4 + (f >> 1)], F[I & 3], o[f & 1], 0, 0, 0); }
        else { constexpr int f = I - 16, sub = f / 12, g = f % 12, d0 = g >> 1, half = g & 1, idx = sub * 2 + half;
            if constexpr (d0 == 0) p[idx] = __builtin_amdgcn_mfma_f32_32x32x16_bf16(F[I & 3], qr[0], negm, 0, 0, 0); else p[idx] = __builtin_amdgcn_mfma_f32_32x32x16_bf16(F[I & 3], qr[d0], p[idx], 0, 0, 0); }
        if constexpr (I + 4 < 40) F[I & 3] = c2_frag<I + 4>(vb, Kb);
        st.template at<I>();
        SBAR();
        if constexpr (I + 1 < 40) C2MSeg<I + 1>::run(o, p, F, pa, qr, negm, vb, Kb, st);
    }
};
template <class ST> __device__ __forceinline__ void c2_mseg(f32x16* o, f32x16 (&p)[4], const bf16x8 (&pa)[8], const bf16x8* qr, const f32x16& negm, int vb, const ALAS unsigned char* Kb, ST& st) {
    bf16x8 F[4]; SBAR();
    F[0] = c2_frag<0>(vb, Kb); F[1] = c2_frag<1>(vb, Kb); F[2] = c2_frag<2>(vb, Kb); F[3] = c2_frag<3>(vb, Kb); SBAR();
    C2MSeg<0>::run(o, p, F, pa, qr, negm, vb, Kb, st);
}
__device__ __forceinline__ float rowmax64(const f32x16 (&p)[4]) {
    float pmax = p[0][0];
#pragma unroll
    for (int i = 0; i < 4; ++i)
#pragma unroll
        for (int r = 0; r < 16; ++r) pmax = fmaxf(pmax, p[i][r]);
    auto rr = __builtin_amdgcn_permlane32_swap(__float_as_uint(pmax), __float_as_uint(pmax), false, false); return fmaxf(__uint_as_float(rr[0]), __uint_as_float(rr[1]));
}
__device__ __forceinline__ void partialSM4_first(f32x16 (&p)[4], float& m_reg, f32x16& negm, float& alpha) {
    const float pmax = rowmax64(p); m_reg = pmax; alpha = 0.f;
#pragma unroll
    for (int i = 0; i < 4; ++i)
#pragma unroll
        for (int r = 0; r < 16; ++r) p[i][r] -= pmax;
#pragma unroll
    for (int r = 0; r < 16; ++r) negm[r] = -pmax;
    asm volatile("" : "+v"(negm));
}
__device__ __forceinline__ void partialSM4_rel(f32x16 (&p)[4], float& m_reg, f32x16& negm, float& alpha) {
    const float pmax = rowmax64(p);
    if (__builtin_expect(__all(pmax <= THR2), 1)) { alpha = 1.f; }
    else { const float dl = fmaxf(pmax, 0.f); m_reg += dl; alpha = __builtin_amdgcn_exp2f(-dl);
#pragma unroll
        for (int i = 0; i < 4; ++i)
#pragma unroll
            for (int r = 0; r < 16; ++r) p[i][r] -= dl;
#pragma unroll
        for (int r = 0; r < 16; ++r) negm[r] = -m_reg;
        asm volatile("" : "+v"(negm)); }
}
__device__ __forceinline__ void finishSM4_pack(f32x16 (&p)[4], float alpha, float& l_reg, bf16x8 (&pa)[8]) {
    float ps = 0.f;
#pragma unroll
    for (int i = 0; i < 4; ++i)
#pragma unroll
        for (int r = 0; r < 16; ++r) { p[i][r] = __builtin_amdgcn_exp2f(p[i][r]); ps += p[i][r]; }
    { auto rr = __builtin_amdgcn_permlane32_swap(__float_as_uint(ps), __float_as_uint(ps), false, false); ps = __uint_as_float(rr[0]) + __uint_as_float(rr[1]); }
    l_reg = l_reg * alpha + ps;
#pragma unroll
    for (int i = 0; i < 4; ++i) {
        { u32x4 w = {cvtpk(p[i][0], p[i][1]), cvtpk(p[i][2], p[i][3]), cvtpk(p[i][4], p[i][5]), cvtpk(p[i][6], p[i][7])}; pa[2 * i] = __builtin_bit_cast(bf16x8, w); }
        { u32x4 w = {cvtpk(p[i][8], p[i][9]), cvtpk(p[i][10], p[i][11]), cvtpk(p[i][12], p[i][13]), cvtpk(p[i][14], p[i][15])}; pa[2 * i + 1] = __builtin_bit_cast(bf16x8, w); } }
}
__device__ __forceinline__ void attn_c_run(const Params& p, int u0, int G, int uend, ALAS unsigned char* lds) {
    const int tid = tid_opaque(), wid = __builtin_amdgcn_readfirstlane(tid >> 6), lane = tid & 63, r32 = lane & 31, hi = lane >> 5;
    if (u0 >= uend) return;
    const bf16_t* qc = (const bf16_t*)(p.ws + WS_QC);
    ALAS unsigned char* K_lds = lds + C_LDS_K; ALAS unsigned char* V_lds = lds + C_LDS_V;
    ALAS float* wsf = (ALAS float*)(lds + C_LDS_WS) + wid * 64; ALAS float* li_l = wsf; ALAS float* al_l = wsf + 32;
    ALAS bf16_t* stg = (ALAS bf16_t*)(lds + C_LDS_STG) + wid * 2048;
    const int sr = tid >> 3, sc = tid & 7, sr2 = tid >> 2, sc2 = 8 + (tid & 3);
    const int kdst = sr * KP96 + sc * 16, kdst2 = sr2 * KP96 + sc2 * 16, vdst = cv_st(sr, sc);
    const int vb0 = (int)(uintptr_t)V_lds + cv_rd_base(lane);
    const ALAS unsigned char* Kb0 = K_lds + r32 * KP96 + hi * 16;
    bf16x8 skA, skB, skR, svA, svB, qr[6];
#define C_UNIT_PTRS(U, KS_, KS2_, VS_, QROW_) do { const int b_ = (U) / 96, h_ = ((U) >> 4) % 6, qb_ = (U) & 15; \
        const bf16_t* kc_ = (const bf16_t*)(p.ws + WS_KC) + (size_t)b_ * SEQ * KC_LD + h_ * 64; const bf16_t* vc_ = (const bf16_t*)(p.ws + WS_VC) + (size_t)b_ * SEQ * VC_LD + h_ * 64; \
        KS_ = kc_ + (size_t)sr * KC_LD + sc * 8; KS2_ = (const bf16_t*)(p.ws + WS_KR) + ((size_t)b_ * SEQ + sr2) * 32 + (sc2 - 8) * 8; VS_ = vc_ + (size_t)sr * VC_LD + sc * 8; QROW_ = (size_t)b_ * SEQ + qb_ * 256 + wid * 32; } while (0)
#define C_SLOAD(t) do { skA = *(const bf16x8*)(ksrc + (size_t)(t) * 128 * KC_LD); skB = *(const bf16x8*)(ksrc + ((size_t)(t) * 128 + 64) * KC_LD); skR = *(const bf16x8*)(ksrc2 + (size_t)(t) * 128 * 32); \
        svA = *(const bf16x8*)(vsrc + (size_t)(t) * 128 * VC_LD); svB = *(const bf16x8*)(vsrc + ((size_t)(t) * 128 + 64) * VC_LD); } while (0)
    const bf16_t* ksrc; const bf16_t* ksrc2; const bf16_t* vsrc; size_t qrow0; int u = u0;
    C_UNIT_PTRS(u, ksrc, ksrc2, vsrc, qrow0);
    C_SLOAD(0);
#pragma unroll
    for (int d0 = 0; d0 < 6; ++d0) qr[d0] = *(const bf16x8*)(qc + (qrow0 + r32) * QC_LD + ((u >> 4) % 6) * 96 + d0 * 16 + hi * 8);
  for (;;) {
    const int h = (u >> 4) % 6;
    float m_reg = 0.f, l_reg = 0.f; f32x16 o[2]; o[0] = f32x16{}; o[1] = f32x16{}; f32x16 negm = f32x16{};
    { const float2* cs = (const float2*)(p.ws + WS_CS) + (qrow0 + r32) * 16;
#pragma unroll
      for (int d0 = 4; d0 < 6; ++d0) { float f[8]; unpack8(__builtin_bit_cast(u32x4, qr[d0]), f);
#pragma unroll
          for (int j = 0; j < 4; ++j) { const float2 c = cs[8 * (d0 - 4) + 4 * hi + j]; const float t1 = f[2 * j], t2 = f[2 * j + 1]; f[2 * j] = t1 * c.x - t2 * c.y; f[2 * j + 1] = t1 * c.y + t2 * c.x; }
          qr[d0] = __builtin_bit_cast(bf16x8, pack8(f)); } }
#define C_SWRITE(ks, vs) do { *(ALAS bf16x8*)(K_lds + (ks) * C2_KB + kdst) = skA; *(ALAS bf16x8*)(K_lds + (ks) * C2_KB + 64 * KP96 + kdst) = skB; *(ALAS bf16x8*)(K_lds + (ks) * C2_KB + kdst2) = skR; \
        *(ALAS bf16x8*)(V_lds + (vs) * C2_VB + vdst) = svA; *(ALAS bf16x8*)(V_lds + (vs) * C2_VB + VTB + vdst) = svB; } while (0)
#define C_HBAR() do { SBAR(); asm volatile("s_waitcnt lgkmcnt(0)" ::: "memory"); __builtin_amdgcn_s_barrier(); asm volatile("" ::: "memory"); SBAR(); } while (0)
    f32x16 pp[4]; float alpha; bf16x8 pa[8]; constexpr int NT = SEQ / 128; const bool lag = wid >= 4;
    int v_prev = 2, v_cur = 0, v_next = 1;
#define C_VROT() do { const int t_ = v_prev; v_prev = v_cur; v_cur = v_next; v_next = t_; } while (0)
#define C_STAGE(T, KSN) do { if ((T) + 1 < NT) { C_SWRITE(KSN, v_next); if ((T) + 2 < NT) C_SLOAD((T) + 2); } } while (0)
#define C_STEP(T, KS) do { \
        const int tl_ = ((T) + 2 < NT) ? (T) + 2 : NT - 1;     \
        C2Stage st_{skA, skB, skR, svA, svB, K_lds + (1 - (KS)) * C2_KB + kdst, K_lds + (1 - (KS)) * C2_KB + kdst2, V_lds + v_next * C2_VB + vdst, \
                    ksrc + (size_t)tl_ * 128 * KC_LD, ksrc2 + (size_t)tl_ * 128 * 32, vsrc + (size_t)tl_ * 128 * VC_LD}; \
        c2_mseg(o, pp, pa, qr, negm, vb0 + v_prev * C2_VB, Kb0 + (KS) * C2_KB, st_); \
        C_HBAR(); \
        partialSM4_rel(pp, m_reg, negm, alpha); ATT_RESC(alpha, al_l); finishSM4_pack(pp, alpha, l_reg, pa); \
        C_HBAR(); C_VROT(); } while (0)
    C_SWRITE(0, 0); C_SLOAD(1); __syncthreads();
    if (lag) C_HBAR();
    C_STAGE(0, 1);
    { qkt<6, KP96>(pp[0], pp[1], K_lds, qr, r32, hi); qkt<6, KP96>(pp[2], pp[3], K_lds + 64 * KP96, qr, r32, hi); }
    C_HBAR();
    partialSM4_first(pp, m_reg, negm, alpha); finishSM4_pack(pp, alpha, l_reg, pa);
    C_HBAR(); C_VROT();
    for (int t = 1; t + 1 < NT; t += 2) { C_STEP(t, 1); C_STEP(t + 1, 0); }
    const int un = u + G; const bf16_t* nks; const bf16_t* nks2; const bf16_t* nvs; size_t nqrow = 0;
    if (un < uend) { C_UNIT_PTRS(un, nks, nks2, nvs, nqrow);
        skA = *(const bf16x8*)(nks); skB = *(const bf16x8*)(nks + (size_t)64 * KC_LD); skR = *(const bf16x8*)(nks2); svA = *(const bf16x8*)(nvs); svB = *(const bf16x8*)(nvs + (size_t)64 * VC_LD); }
    { C2NoStage ns_; c2_mseg(o, pp, pa, qr, negm, vb0 + v_prev * C2_VB, Kb0 + C2_KB, ns_); }
    if (un < uend) {
#pragma unroll
        for (int d0 = 0; d0 < 6; ++d0) qr[d0] = *(const bf16x8*)(qc + (nqrow + r32) * QC_LD + ((un >> 4) % 6) * 96 + d0 * 16 + hi * 8); }
    C_HBAR();
    partialSM4_rel(pp, m_reg, negm, alpha); ATT_RESC(alpha, al_l); finishSM4_pack(pp, alpha, l_reg, pa);
    C_HBAR(); C_VROT();
    u32x4 gpre[4];
    { const bf16_t* projg = (const bf16_t*)(p.ws + WS_PROJ);
#pragma unroll
      for (int i = 0; i < 4; ++i) gpre[i] = *(const u32x4*)(projg + (qrow0 + i * 8 + (lane >> 3)) * NP + C_GC + h * 64 + (lane & 7) * 8); }
    { const int vbl = vb0 + v_prev * C2_VB;
#pragma unroll
      for (int sub = 0; sub < 2; ++sub)
#pragma unroll
        for (int ks = 0; ks < 4; ++ks) { o[0] = __builtin_amdgcn_mfma_f32_32x32x16_bf16(pa[sub * 4 + ks], c_frag_rt(vbl + sub * VTB, 0, ks), o[0], 0, 0, 0); o[1] = __builtin_amdgcn_mfma_f32_32x32x16_bf16(pa[sub * 4 + ks], c_frag_rt(vbl + sub * VTB, 1, ks), o[1], 0, 0, 0); } }
    if (!lag) C_HBAR();
    if (hi == 0) li_l[r32] = l_reg; asm volatile("s_waitcnt lgkmcnt(0)" ::: "memory");
#pragma unroll
    for (int r = 0; r < 16; ++r) { const int orow = crow(r, hi); const float rl = __builtin_amdgcn_rcpf(li_l[orow]);
#pragma unroll
        for (int d0 = 0; d0 < 2; ++d0) stg[orow * 64 + d0 * 32 + r32] = (bf16_t)f2bf(o[d0][r] * rl); }
    asm volatile("s_waitcnt lgkmcnt(0)" ::: "memory");
    const bf16_t* proj = (const bf16_t*)(p.ws + WS_PROJ); bf16_t* ym = (bf16_t*)(p.ws + WS_YMIX);
#pragma unroll
    for (int i = 0; i < 4; ++i) { const int row = i * 8 + (lane >> 3), ch = lane & 7; const size_t tok = qrow0 + row;
        const u32x4 ov = *(const ALAS u32x4*)(stg + row * 64 + ch * 8); const u32x4 gv = gpre[i];
        float of[8], gf[8]; unpack8(ov, of); unpack8(gv, gf);
#pragma unroll
        for (int j = 0; j < 8; ++j) of[j] *= silu_f(gf[j]);
        *(u32x4*)(ym + tok * DM + 640 + h * 64 + ch * 8) = pack8(of); }
    __syncthreads();
    if (un >= uend) break;
    u = un; ksrc = nks; ksrc2 = nks2; vsrc = nvs; qrow0 = nqrow;
  }
#undef C_UNIT_PTRS
#undef C_VROT
#undef C_STAGE
#undef C_STEP
#undef C_HBAR
#undef C_SLOAD
#undef C_SWRITE
}

template <int F> __device__ __forceinline__ bf16x8 bq_frag(const ALAS unsigned char* Kb) { constexpr int d0 = F >> 1, half = F & 1; return *(const ALAS bf16x8*)(Kb + half * 32 * KP64 + d0 * 32); }
template <int F> __device__ __forceinline__ bf16x8 bv_frag(int vb) { constexpr int d0 = F & 1, ks = F >> 1; const s16x4 l = tr_read<v_rd_off(d0, ks, 0)>(vb), h = tr_read<v_rd_off(d0, ks, 1)>(vb); return (bf16x8){l[0], l[1], l[2], l[3], h[0], h[1], h[2], h[3]}; }
template <int I> struct BandQK { static __device__ __forceinline__ void run(f32x16& p0, f32x16& p1, bf16x8 (&F)[4], const bf16x8* qr, const ALAS unsigned char* Kb) {
        constexpr int d0 = I >> 1, half = I & 1;
        if constexpr (half == 0) { if constexpr (d0 == 0) p0 = __builtin_amdgcn_mfma_f32_32x32x16_bf16(F[I & 3], qr[0], f32x16{}, 0, 0, 0); else p0 = __builtin_amdgcn_mfma_f32_32x32x16_bf16(F[I & 3], qr[d0], p0, 0, 0, 0); }
        else { if constexpr (d0 == 0) p1 = __builtin_amdgcn_mfma_f32_32x32x16_bf16(F[I & 3], qr[0], f32x16{}, 0, 0, 0); else p1 = __builtin_amdgcn_mfma_f32_32x32x16_bf16(F[I & 3], qr[d0], p1, 0, 0, 0); }
        if constexpr (I + 4 < 8) F[I & 3] = bq_frag<I + 4>(Kb);
        SBAR();
        if constexpr (I + 1 < 8) BandQK<I + 1>::run(p0, p1, F, qr, Kb); } };
__device__ __forceinline__ void band_qk(f32x16& p0, f32x16& p1, const bf16x8* qr, const ALAS unsigned char* Kb) {
    bf16x8 F[4]; SBAR(); F[0] = bq_frag<0>(Kb); F[1] = bq_frag<1>(Kb); F[2] = bq_frag<2>(Kb); F[3] = bq_frag<3>(Kb); SBAR();
    BandQK<0>::run(p0, p1, F, qr, Kb);
}
template <int I> struct BandPV { static __device__ __forceinline__ void run(f32x16* o, bf16x8 (&F)[4], const bf16x8 (&pa)[4], int vb) {
        o[I & 1] = __builtin_amdgcn_mfma_f32_32x32x16_bf16(pa[I >> 1], F[I & 3], o[I & 1], 0, 0, 0);
        if constexpr (I + 4 < 8) F[I & 3] = bv_frag<I + 4>(vb);
        SBAR();
        if constexpr (I + 1 < 8) BandPV<I + 1>::run(o, F, pa, vb); } };
template <int F> __device__ __forceinline__ bf16x8 bq_frag3(const ALAS unsigned char* Kb) { constexpr int t = F >> 3, f = F & 7, d0 = f >> 1, half = f & 1; return *(const ALAS bf16x8*)(Kb + t * (64 * KP64) + half * 32 * KP64 + d0 * 32); }
template <int F> __device__ __forceinline__ bf16x8 bv_frag3(int vb) { constexpr int t = F >> 3, f = F & 7, d0 = f & 1, ks = f >> 1; const s16x4 l = tr_read<t * VTB + v_rd_off(d0, ks, 0)>(vb), h = tr_read<t * VTB + v_rd_off(d0, ks, 1)>(vb); return (bf16x8){l[0], l[1], l[2], l[3], h[0], h[1], h[2], h[3]}; }
template <int I> struct BandQK3 { static __device__ __forceinline__ void run(f32x16 (&P)[3][2], bf16x8 (&F)[4], const bf16x8* qr, const ALAS unsigned char* Kb) {
        constexpr int t = I >> 3, f = I & 7, d0 = f >> 1, half = f & 1;
        if constexpr (d0 == 0) P[t][half] = __builtin_amdgcn_mfma_f32_32x32x16_bf16(F[I & 3], qr[0], f32x16{}, 0, 0, 0); else P[t][half] = __builtin_amdgcn_mfma_f32_32x32x16_bf16(F[I & 3], qr[d0], P[t][half], 0, 0, 0);
        if constexpr (I + 4 < 24) F[I & 3] = bq_frag3<I + 4>(Kb);
        SBAR();
        if constexpr (I + 1 < 24) BandQK3<I + 1>::run(P, F, qr, Kb); } };
__device__ __forceinline__ void band_qk3(f32x16 (&P)[3][2], const bf16x8* qr, const ALAS unsigned char* Kb) {
    bf16x8 F[4]; SBAR(); F[0] = bq_frag3<0>(Kb); F[1] = bq_frag3<1>(Kb); F[2] = bq_frag3<2>(Kb); F[3] = bq_frag3<3>(Kb); SBAR();
    BandQK3<0>::run(P, F, qr, Kb);
}
template <int I> struct BandPV3 { static __device__ __forceinline__ void run(f32x16* o, bf16x8 (&F)[4], const bf16x8 (&pa)[3][4], int vb) {
        constexpr int t = I >> 3, f = I & 7;
        if constexpr (I < 2) o[f & 1] = __builtin_amdgcn_mfma_f32_32x32x16_bf16(pa[t][f >> 1], F[I & 3], f32x16{}, 0, 0, 0); else o[f & 1] = __builtin_amdgcn_mfma_f32_32x32x16_bf16(pa[t][f >> 1], F[I & 3], o[f & 1], 0, 0, 0);
        if constexpr (I + 4 < 24) F[I & 3] = bv_frag3<I + 4>(vb);
        SBAR();
        if constexpr (I + 1 < 24) BandPV3<I + 1>::run(o, F, pa, vb); } };
__device__ __forceinline__ void band_softmax3(f32x16 (&P)[3][2], float& m_reg, float& l_reg, bf16x8 (&pa)[3][4]) {
    float mx[3];
#pragma unroll
    for (int t = 0; t < 3; ++t) { mx[t] = P[t][0][0];
#pragma unroll
        for (int r = 1; r < 16; ++r) mx[t] = fmaxf(mx[t], P[t][0][r]);
#pragma unroll
        for (int r = 0; r < 16; ++r) mx[t] = fmaxf(mx[t], P[t][1][r]); }
    float pmax = fmaxf(fmaxf(mx[0], mx[1]), mx[2]);
    { auto rr = __builtin_amdgcn_permlane32_swap(__float_as_uint(pmax), __float_as_uint(pmax), false, false); pmax = fmaxf(__uint_as_float(rr[0]), __uint_as_float(rr[1])); }
    m_reg = pmax;
    float ps[3];
#pragma unroll
    for (int t = 0; t < 3; ++t) { ps[t] = 0.f;
#pragma unroll
        for (int h = 0; h < 2; ++h)
#pragma unroll
            for (int r = 0; r < 16; ++r) { P[t][h][r] = __builtin_amdgcn_exp2f(P[t][h][r] - pmax); ps[t] += P[t][h][r]; } }
    float psum = (ps[0] + ps[1]) + ps[2];
    { auto rr = __builtin_amdgcn_permlane32_swap(__float_as_uint(psum), __float_as_uint(psum), false, false); psum = __uint_as_float(rr[0]) + __uint_as_float(rr[1]); }
    l_reg = psum;
#define ATT_PK4(PP, BASE, OUT) do { unsigned a0 = cvtpk(PP[BASE + 0], PP[BASE + 1]), a1 = cvtpk(PP[BASE + 2], PP[BASE + 3]); \
    unsigned b0 = cvtpk(PP[BASE + 4], PP[BASE + 5]), b1 = cvtpk(PP[BASE + 6], PP[BASE + 7]); \
    auto r0 = __builtin_amdgcn_permlane32_swap(a0, b0, false, false); auto r1 = __builtin_amdgcn_permlane32_swap(a1, b1, false, false); \
    u32x4 w = {r0[0], r1[0], r0[1], r1[1]}; OUT = __builtin_bit_cast(bf16x8, w); } while (0)
#pragma unroll
    for (int t = 0; t < 3; ++t) { ATT_PK4(P[t][0], 0, pa[t][0]); ATT_PK4(P[t][0], 8, pa[t][1]); ATT_PK4(P[t][1], 0, pa[t][2]); ATT_PK4(P[t][1], 8, pa[t][3]); }
#undef ATT_PK4
}
template <int C> __device__ __forceinline__ float add_const(float a) { float r; asm("v_add_f32_e32 %0, %2, %1" : "=v"(r) : "v"(a), "n"(__builtin_bit_cast(int, (float)C))); return r; }
__device__ __forceinline__ float fma_abs(float a, float b_abs, float c) { float r; asm("v_fma_f32 %0, %1, |%2|, %3" : "=v"(r) : "v"(a), "v"(b_abs), "v"(c)); return r; }
template <int R> __device__ __forceinline__ void band_bias(f32x16& p0, f32x16& p1, float relb, float nsl) {
    constexpr int C = (R & 3) + 8 * (R >> 2);
    p0[R] = fma_abs(nsl, add_const<C>(relb), p0[R]); p1[R] = fma_abs(nsl, add_const<C + 32>(relb), p1[R]);
    if constexpr (R + 1 < 16) band_bias<R + 1>(p0, p1, relb, nsl);
}
template <int R, int W> __device__ __forceinline__ void band_bias_maskc(f32x16& p0, f32x16& p1, float relb, float nsl, float ninf) {
    constexpr int C = (R & 3) + 8 * (R >> 2);
    const float r0 = add_const<C>(relb), r1 = add_const<C + 32>(relb);
    const float v0 = fma_abs(nsl, r0, p0[R]), v1 = fma_abs(nsl, r1, p1[R]);
    p0[R] = (__builtin_fabsf(r0) <= (float)W) ? v0 : ninf; p1[R] = (__builtin_fabsf(r1) <= (float)W) ? v1 : ninf;
    if constexpr (R + 1 < 16) band_bias_maskc<R + 1, W>(p0, p1, relb, nsl, ninf);
}
template <int R> __device__ __forceinline__ void band_bias_mask(f32x16& p0, f32x16& p1, float relb, float relbm, float hwf, float nsl, float ninf) {
    constexpr int C = (R & 3) + 8 * (R >> 2);
    const float v0 = fma_abs(nsl, add_const<C>(relb), p0[R]), v1 = fma_abs(nsl, add_const<C + 32>(relb), p1[R]);
    p0[R] = (__builtin_fabsf(add_const<C>(relbm)) <= hwf) ? v0 : ninf; p1[R] = (__builtin_fabsf(add_const<C + 32>(relbm)) <= hwf) ? v1 : ninf;
    if constexpr (R + 1 < 16) band_bias_mask<R + 1>(p0, p1, relb, relbm, hwf, nsl, ninf);
}
enum { BK_A_PART = 0, BK_A_MERGE = 1, BK_B = 2 };
struct BandU { const bf16_t* q; const bf16_t* k; const bf16_t* v; bf16_t* opart; float* lsepart; size_t rs, tok0; int d, Q0, L, h; float slope2; };
constexpr int BL_KT = 64 * KP64, BL_V = 8 * BL_KT, BL_WS = BL_V + 8 * VTB, BL_STG = BL_WS + 8 * 512, BL_END = BL_STG + 8 * 2048;
__device__ __forceinline__ void band_make_a(const Params& p, int pat, int u, BandU& D) {
    const int d = pat == 0 ? 1 : (pat == 1 ? 4 : 16), b = u >> 6, h = (u >> 4) & 3, w = u & 15, r = w % d, nb = w / d;
    const bf16_t* proj = (const bf16_t*)(p.ws + WS_PROJ) + ((size_t)b * SEQ + r) * NP;
    D.q = proj + C_QA + h * 64; D.k = proj + C_KA + h * 64; D.v = proj + C_VA + h * 64; D.rs = (size_t)d * NP; D.tok0 = (size_t)b * SEQ + r; D.d = d; D.Q0 = 256 * nb; D.L = SEQ / d; D.h = h;
    D.slope2 = slope_all(6 + h) * LOG2E * (float)d;
    D.opart = (bf16_t*)(p.ws + (pat == 0 ? WS_OA1 : WS_OA2)); D.lsepart = (float*)(p.ws + (pat == 0 ? WS_LSE1 : WS_LSE2));
}
__device__ __forceinline__ void band_make_b(const Params& p, int u, BandU& D) {
    const int b = u >> 5, g = (u >> 4) & 1, nb = u & 15;
    const bf16_t* proj = (const bf16_t*)(p.ws + WS_PROJ) + (size_t)b * SEQ * NP;
    D.q = proj + C_QB + g * 192; D.k = proj + C_KB + g * 64; D.v = proj + C_VB + g * 64; D.rs = NP; D.tok0 = (size_t)b * SEQ; D.d = 1; D.Q0 = 256 * nb; D.L = SEQ; D.h = g * 3; D.slope2 = 0.f; D.opart = nullptr; D.lsepart = nullptr;
}
template <int KIND> __device__ __forceinline__ bool band_item(const Params& p, int k, BandU& D) {
    int G = gridDim.x, bx = blockIdx.x, c = (G % 8 == 0) ? (bx % 8) * (G / 8) + bx / 8 : bx, baseA = 0, baseB = 0, totA = 512, totB = 256;
    if (G == 256) { baseA = 64 * (bx % 8); baseB = 32 * (bx % 8); totA = 64; totB = 32; c = bx / 8; G = 32; }
    const int nA = c < totA ? (totA - c + G - 1) / G : 0, nB = c < totB ? (totB - c + G - 1) / G : 0;
    if (KIND == BK_A_PART) { if (k >= 2 * nA) return false; if (k < nA) band_make_a(p, 0, baseA + c + k * G, D); else band_make_a(p, 1, baseA + c + (k - nA) * G, D); return true; }
    if (KIND == BK_A_MERGE) { if (k >= nA) return false; band_make_a(p, 2, baseA + c + k * G, D); return true; }
    if (k >= nB) return false; band_make_b(p, baseB + c + k * G, D); return true;
}
template <int KIND> __device__ __forceinline__ void band_run(const Params& p, int layer, ALAS unsigned char* lds) {
    constexpr int NTILE = KIND == BK_B ? 8 : 6, NTW = KIND == BK_B ? 5 : 3, W = KIND == BK_B ? 128 : 64, NH = KIND == BK_B ? 3 : 1;
    constexpr int NPF = 6;
    constexpr bool PREFETCH = KIND != BK_B;
    const int tid = tid_opaque(), wid = __builtin_amdgcn_readfirstlane(tid >> 6), lane = tid & 63, r32 = lane & 31, hi = lane >> 5;
    ALAS unsigned char* K_lds = lds; ALAS unsigned char* V_lds = lds + BL_V;
    ALAS float* wsf = (ALAS float*)(lds + BL_WS) + wid * 128; ALAS float* li_l = wsf; ALAS float* al_l = wsf + 32;
    ALAS bf16_t* stg = (ALAS bf16_t*)(lds + BL_STG) + wid * 1024;
    const int vb0 = (int)(uintptr_t)V_lds + v_rd_base(lane);
    const int sr = tid >> 3, sc = tid & 7;
    const float ninf = -__builtin_inff();
    const bf16_t* proj = (const bf16_t*)(p.ws + WS_PROJ); bf16_t* ym = (bf16_t*)(p.ws + WS_YMIX);
    BandU D; int k = 0; bool have = band_item<KIND>(p, 0, D);
    bf16x8 sk[NTILE], sv[NTILE];
#define BAND_LOADR(DD, I0, I1) do { _Pragma("unroll") for (int it = (I0); it < (I1); ++it) { int jk = (DD).Q0 - W + it * 64 + sr; jk = jk < 0 ? 0 : (jk >= (DD).L ? (DD).L - 1 : jk); \
        sk[it] = *(const bf16x8*)((DD).k + (size_t)jk * (DD).rs + sc * 8); sv[it] = *(const bf16x8*)((DD).v + (size_t)jk * (DD).rs + sc * 8); } } while (0)
    if (have) BAND_LOADR(D, 0, PREFETCH ? NPF : NTILE);
    while (have) {
        if (PREFETCH) BAND_LOADR(D, NPF, NTILE);
#pragma unroll
        for (int it = 0; it < NTILE; ++it) { *(ALAS bf16x8*)(K_lds + it * BL_KT + sr * KP64 + sc * 16) = sk[it]; *(ALAS bf16x8*)(V_lds + it * VTB + v_st(sr, sc * 8)) = sv[it]; }
        const int jq = D.Q0 + wid * 32 + r32;
        const size_t tokl = D.tok0 + (size_t)D.d * jq;
        bf16x8 qr[4];
#pragma unroll
        for (int d0 = 0; d0 < 4; ++d0) qr[d0] = *(const bf16x8*)(D.q + (size_t)jq * D.rs + d0 * 16 + hi * 8);
        __syncthreads();
        const int lo_i = (-W > -jq) ? -W : -jq, hi_i = (W < D.L - 1 - jq) ? W : D.L - 1 - jq;
        const float midf = 0.5f * (float)(lo_i + hi_i), hwf = 0.5f * (float)(hi_i - lo_i);
        const bool centered = (D.Q0 - W >= 0) && (D.Q0 + 255 + W < D.L);
#pragma unroll 1
        for (int hh = 0; hh < NH; ++hh) {
            const int hcur = D.h + hh; const float slope2 = (KIND == BK_B) ? slope_all(hcur) * LOG2E : D.slope2;
            float m_reg = -1e30f, l_reg = 0.f; f32x16 o[2]; o[0] = f32x16{}; o[1] = f32x16{};
            u32x4 gpre[2][2], f1pre[2][2], f2pre[2][2]; float l1 = 0.f, l2 = 0.f; bf16x8 qn[4];
            if constexpr (KIND == BK_B) {
#pragma unroll
                for (int i = 0; i < 2; ++i) { const size_t tok = D.tok0 + (size_t)D.d * (D.Q0 + wid * 32 + i * 16 + (lane >> 2));
#pragma unroll
                    for (int d0 = 0; d0 < 2; ++d0) gpre[d0][i] = *(const u32x4*)(proj + tok * NP + C_GB + hcur * 64 + d0 * 32 + (lane & 3) * 8); }
                const int hn = (hh + 1 < NH) ? hh + 1 : hh;
#pragma unroll
                for (int d0 = 0; d0 < 4; ++d0) qn[d0] = *(const bf16x8*)(D.q + (size_t)jq * D.rs + hn * 64 + d0 * 16 + hi * 8); }
            if constexpr (NH == 1) {
                const int jt0 = wid >> 1; f32x16 P[3][2]; bf16x8 pa3[3][4];
                band_qk3(P, qr, K_lds + jt0 * BL_KT + r32 * KP64 + hi * 16);
                asm volatile("s_nop 15\n\ts_nop 7" : "+v"(P[0][0]), "+v"(P[0][1]), "+v"(P[1][0]), "+v"(P[1][1]), "+v"(P[2][0]), "+v"(P[2][1]));
                const float nsl = -slope2;
#pragma unroll
                for (int jj = 0; jj < 3; ++jj) { const int jt = jt0 + jj;
                    const float relb = (float)(64 * jt - W - 32 * wid - r32 + 4 * hi);
                    const int kt0 = D.Q0 - W + 64 * jt;
                    const bool interior = (64 * jt >= 32 * wid + 31) && (64 * jt + 63 <= 2 * W + 32 * wid) && (kt0 >= 0) && (kt0 + 63 < D.L);
                    if (interior) { band_bias<0>(P[jj][0], P[jj][1], relb, nsl);
                    } else if (centered) { band_bias_maskc<0, W>(P[jj][0], P[jj][1], relb, nsl, ninf);
                    } else { band_bias_mask<0>(P[jj][0], P[jj][1], relb, relb - midf, hwf, nsl, ninf); } }
                band_softmax3(P, m_reg, l_reg, pa3);
                { const int vbt = vb0 + jt0 * VTB; bf16x8 VF[4]; SBAR(); VF[0] = bv_frag3<0>(vbt); VF[1] = bv_frag3<1>(vbt); VF[2] = bv_frag3<2>(vbt); VF[3] = bv_frag3<3>(vbt); SBAR();
                  BandPV3<0>::run(o, VF, pa3, vbt); }
            } else
#pragma unroll 1
            for (int jj = 0; jj < NTW; ++jj) { const int jt = (wid >> 1) + jj;
                f32x16 p0, p1; float alpha; bf16x8 pa[4], VF[4];
                band_qk(p0, p1, qr, K_lds + jt * BL_KT + r32 * KP64 + hi * 16);
                const int vbt = vb0 + jt * VTB;
                VF[0] = bv_frag<0>(vbt); VF[1] = bv_frag<1>(vbt); VF[2] = bv_frag<2>(vbt); VF[3] = bv_frag<3>(vbt); SBAR();
                const float relb = (float)(64 * jt - W - 32 * wid - r32 + 4 * hi);
                const int kt0 = D.Q0 - W + 64 * jt;
                const bool interior = (64 * jt >= 32 * wid + 31) && (64 * jt + 63 <= 2 * W + 32 * wid) && (kt0 >= 0) && (kt0 + 63 < D.L);
                asm volatile("s_nop 15\n\ts_nop 7" : "+v"(p0), "+v"(p1));
                const float nsl = -slope2;
                if (interior) { band_bias<0>(p0, p1, relb, nsl);
                } else if (centered) { band_bias_maskc<0, W>(p0, p1, relb, nsl, ninf);
                } else { band_bias_mask<0>(p0, p1, relb, relb - midf, hwf, nsl, ninf); }
                partialSM(p0, p1, m_reg, alpha);
                ATT_RESC(alpha, al_l);
                finishSM(p0, p1, alpha, l_reg, pa[0], pa[1], pa[2], pa[3]); SBAR();
                BandPV<0>::run(o, VF, pa, vbt);
            }
            if (PREFETCH) { BandU Dn; if (band_item<KIND>(p, k + 1, Dn)) BAND_LOADR(Dn, 0, NPF); }
            if (KIND == BK_A_MERGE) { l1 = ((const float*)(p.ws + WS_LSE1))[tokl * 4 + hcur]; l2 = ((const float*)(p.ws + WS_LSE2))[tokl * 4 + hcur]; }
#pragma unroll
            for (int i = 0; i < 2; ++i) { const size_t tok = D.tok0 + (size_t)D.d * (D.Q0 + wid * 32 + i * 16 + (lane >> 2));
#pragma unroll
                for (int d0 = 0; d0 < 2; ++d0) { const int col = d0 * 32 + (lane & 3) * 8;
                    if (KIND == BK_A_MERGE) { gpre[d0][i] = *(const u32x4*)(proj + tok * NP + C_GA + hcur * 64 + col);
                        f1pre[d0][i] = *(const u32x4*)((const bf16_t*)(p.ws + WS_OA1) + tok * 256 + hcur * 64 + col); f2pre[d0][i] = *(const u32x4*)((const bf16_t*)(p.ws + WS_OA2) + tok * 256 + hcur * 64 + col); } } }
            float mult;
            if (KIND == BK_B) { const float sk2 = p.sink[layer * 6 + hcur] * LOG2E, M = fmaxf(m_reg, sk2), e = __builtin_amdgcn_exp2f(m_reg - M), den = l_reg * e + __builtin_amdgcn_exp2f(sk2 - M); mult = e / den; }
            else mult = 1.f / l_reg;
            if (hi == 0) li_l[r32] = mult;
            if (KIND == BK_A_PART) { if (hi == 0) D.lsepart[tokl * 4 + hcur] = m_reg + __builtin_amdgcn_logf(l_reg); }
            if (KIND == BK_A_MERGE) { if (hi == 0) { const float l3 = m_reg + __builtin_amdgcn_logf(l_reg);
                    const float Mx = fmaxf(fmaxf(l1, l2), l3), e1 = __builtin_amdgcn_exp2f(l1 - Mx), e2 = __builtin_amdgcn_exp2f(l2 - Mx), e3 = __builtin_amdgcn_exp2f(l3 - Mx), inv = 1.f / (e1 + e2 + e3);
                    wsf[32 + r32] = e1 * inv; wsf[64 + r32] = e2 * inv; wsf[96 + r32] = e3 * inv; } }
            asm volatile("s_waitcnt lgkmcnt(0)" ::: "memory");
#pragma unroll
            for (int d0 = 0; d0 < 2; ++d0) {
#pragma unroll
                for (int r = 0; r < 16; ++r) stg[crow(r, hi) * 32 + r32] = (bf16_t)f2bf(o[d0][r] * li_l[crow(r, hi)]);
                asm volatile("s_waitcnt lgkmcnt(0)" ::: "memory");
#pragma unroll
                for (int i = 0; i < 2; ++i) { const int row = i * 16 + (lane >> 2), ch = lane & 3, col = d0 * 32 + ch * 8; const size_t tok = D.tok0 + (size_t)D.d * (D.Q0 + wid * 32 + row);
                    const u32x4 ov = *(const ALAS u32x4*)(stg + row * 32 + ch * 8);
                    if (KIND == BK_A_PART) { *(u32x4*)(D.opart + tok * 256 + hcur * 64 + col) = ov; }
                    else { float of[8], gf[8]; unpack8(ov, of);
                        if (KIND == BK_A_MERGE) { const float w1 = wsf[32 + row], w2 = wsf[64 + row], w3 = wsf[96 + row]; float f1[8], f2[8]; unpack8(f1pre[d0][i], f1); unpack8(f2pre[d0][i], f2);
#pragma unroll
                            for (int j = 0; j < 8; ++j) of[j] = w3 * of[j] + w1 * f1[j] + w2 * f2[j]; }
                        unpack8(gpre[d0][i], gf);
#pragma unroll
                        for (int j = 0; j < 8; ++j) of[j] *= silu_f(gf[j]);
                        *(u32x4*)(ym + tok * DM + (KIND == BK_B ? 256 : 0) + hcur * 64 + col) = pack8(of); } }
                asm volatile("s_waitcnt lgkmcnt(0)" ::: "memory"); }
            if constexpr (KIND == BK_B) {
#pragma unroll
                for (int d0 = 0; d0 < 4; ++d0) qr[d0] = qn[d0]; }
        }
        __syncthreads();
        ++k;
        have = band_item<KIND>(p, k, D); if (!PREFETCH && have) BAND_LOADR(D, 0, NTILE);
    }
#undef BAND_LOADR
}
#undef SBAR
}

constexpr int LDS_BYTES = 163840;
#define LAS __attribute__((address_space(3)))
__device__ __forceinline__ const bf16_t* w_in_t(const Params& p, int l) { return (const bf16_t*)(p.ws + WS_WIN) + (size_t)l * NP * DM; }
__device__ __forceinline__ const bf16_t* w_uq_t(const Params& p, int l) { return (const bf16_t*)(p.ws + WS_WUQ) + (size_t)l * 768 * 256; }
__device__ __forceinline__ const bf16_t* w_ukv_t(const Params& p, int l) { return (const bf16_t*)(p.ws + WS_WUKV) + (size_t)l * 768 * 256; }
__device__ __forceinline__ const bf16_t* w_o_t(const Params& p, int l) { return (const bf16_t*)(p.ws + WS_WO) + (size_t)l * DM * DM; }

__device__ __forceinline__ void ph_gemm1(const Params& p, int layer, LAS unsigned char* lds) {
    pg8::Gemm g{(const bf16_t*)(p.ws + WS_XB), w_in_t(p, layer), DM, DM, DM};
    pg8::StaticOrder S; S.init(T, NP, (int)gridDim.x, (int)blockIdx.x, WGM_GEMM1);
    typedef pg8::EpiWrap<EpProj, true> E_t; E_t E{EpProj{(bf16_t*)(p.ws + WS_PROJ)}, (float*)(p.ws + WS_PARTQ), (float*)(p.ws + WS_PARTKV)};
    pg8::gemm_phase<E_t, pg8::StaticOrder, true, true>(lds, g, S, E);
}
__device__ __forceinline__ void ph_up(const Params& p, int layer, LAS unsigned char* lds, bool bmap) {
    { pg8::Gemm g{(const bf16_t*)(p.ws + WS_PROJ) + C_CQ, w_uq_t(p, layer), NP, 256, 256};
      pg8::RangeOrder S; if (bmap) { S.init(0, 48, 3, (int)gridDim.x / 8, (int)blockIdx.x / 8); S.pm0 = 16 * ((int)blockIdx.x % 8); } else S.init(0, 384, 3, (int)gridDim.x, (int)blockIdx.x);
      typedef pg8::EpiWrap<EpQ, false, true> E_t; E_t E{EpQ{(bf16_t*)(p.ws + WS_QC), (const float*)(p.ws + WS_PARTQ)}, nullptr, nullptr};
      pg8::gemm_phase<E_t, pg8::RangeOrder, true, true>(lds, g, S, E); }
    { pg8::Gemm g{(const bf16_t*)(p.ws + WS_PROJ) + C_CKV, w_ukv_t(p, layer), NP, 256, 256};
      pg8::RangeOrder S; if (bmap) { S.init(48, 48, 3, (int)gridDim.x / 8, (int)blockIdx.x / 8); S.pm0 = 16 * ((int)blockIdx.x % 8); } else S.init(384, 384, 3, (int)gridDim.x, (int)blockIdx.x);
      typedef pg8::EpiWrap<EpKV, false, true> E_t; E_t E{EpKV{(bf16_t*)(p.ws + WS_KC), (bf16_t*)(p.ws + WS_VC), (const float*)(p.ws + WS_PARTKV)}, nullptr, nullptr};
      pg8::gemm_phase<E_t, pg8::RangeOrder, true, true>(lds, g, S, E); }
}
__device__ __forceinline__ void ph_out(const Params& p, int layer, LAS unsigned char* lds) {
    pg8::Gemm g{(const bf16_t*)(p.ws + WS_YMIX), w_o_t(p, layer), DM, DM, DM};
    pg8::StaticOrder S; S.init(T, DM, (int)gridDim.x, (int)blockIdx.x, WGM_OUT);
    typedef pg8::EpiWrap<EpY, false> E_t; E_t E{EpY{(bf16_t*)(p.ws + WS_Y)}, nullptr, nullptr};
    pg8::gemm_phase<E_t, pg8::StaticOrder, true, true>(lds, g, S, E);
}
#define XB_TMO      128
#define XB_XCNT(j)  (256  + 64 * (j))
#define XB_XSUB(j)  (1280 + 64 * (j))
#define XB_XGEN(j)  (2304 + 64 * (j))
#define XB_TOP      3328
#define XB_TOPGEN   3392
#define XCD_BAR_WORDS 3456
#define XB_SPIN_CAP (1u << 21)

__device__ __forceinline__ unsigned xb_ld(unsigned* p)              { return __hip_atomic_load(p, __ATOMIC_RELAXED, __HIP_MEMORY_SCOPE_AGENT); }
__device__ __forceinline__ unsigned xb_add(unsigned* p, unsigned v) { return __hip_atomic_fetch_add(p, v, __ATOMIC_RELAXED, __HIP_MEMORY_SCOPE_AGENT); }
__device__ __forceinline__ unsigned xb_xcc_id() { return (unsigned)__builtin_amdgcn_s_getreg((3 << 11) | 20) & 0xFu; }
#define XB_SPIN(cond, bar) do { unsigned _sp = 0; while (cond) { __builtin_amdgcn_s_sleep(1); \
    if ((++_sp & 255u) == 0u) { if (xb_ld(&(bar)[XB_TMO])) break; if (_sp > XB_SPIN_CAP) { atomicAdd(&(bar)[XB_TMO], 1u); break; } } } } while (0)

struct XcdBarrier {
    unsigned* bar; unsigned x;
    volatile LAS unsigned* st;
};

__device__ __forceinline__ XcdBarrier xcd_barrier_post(unsigned* bar, volatile LAS unsigned* st) {
    XcdBarrier b; b.bar = bar; b.x = xb_xcc_id(); b.st = st;
    if (threadIdx.x == 0) (void)xb_add(&bar[XB_XCNT(b.x)], 1u);
    return b;
}
__device__ __forceinline__ void xcd_barrier_complete(unsigned* bar, unsigned x, unsigned& nloc, unsigned& nx) {
    const unsigned G = gridDim.x * gridDim.y * gridDim.z;
    unsigned sum, cnt, mine, sp = 0u;
    for (;;) {
        sum = 0u; cnt = 0u; mine = 0u;
#pragma unroll
        for (unsigned j = 0; j < 16; ++j) { const unsigned c = xb_ld(&bar[XB_XCNT(j)]); sum += c; cnt += (c > 0u) ? 1u : 0u; mine = (j == x) ? c : mine; }
        if (sum == G) break;
        __builtin_amdgcn_s_sleep(1);
        if ((++sp & 255u) == 0u) { if (xb_ld(&bar[XB_TMO])) break; if (sp > XB_SPIN_CAP) { atomicAdd(&bar[XB_TMO], 1u); break; } }
    }
    nloc = mine > 0u ? mine : 1u; nx = cnt > 0u ? cnt : 1u;
}

__device__ __forceinline__ void xcd_barrier(const XcdBarrier& b) {
    asm volatile("s_waitcnt vmcnt(0)" ::: "memory");
    __syncthreads();
    if (threadIdx.x == 0) {
        unsigned* bar = b.bar;
        __builtin_amdgcn_s_waitcnt(0);
        unsigned nloc = b.st[0], nx = b.st[1];
        if (nloc == 0u) { xcd_barrier_complete(bar, b.x, nloc, nx); b.st[0] = nloc; b.st[1] = nx; }
        const unsigned old = xb_add(&bar[XB_XSUB(b.x)], 1u);
        const unsigned gen = old / nloc;
        if (old + 1u == (gen + 1u) * nloc) {
            __builtin_amdgcn_fence(__ATOMIC_RELEASE, "agent");
            asm volatile("s_waitcnt vmcnt(0)" ::: "memory");
            const unsigned og = xb_add(&bar[XB_TOP], 1u);
            const unsigned tg = og / nx;
            if (og + 1u == (tg + 1u) * nx) xb_add(&bar[XB_TOPGEN], 1u);
            else XB_SPIN(xb_ld(&bar[XB_TOPGEN]) == tg, bar);
            __builtin_amdgcn_fence(__ATOMIC_ACQUIRE, "agent");
            xb_add(&bar[XB_XGEN(b.x)], 1u);
            asm volatile("s_waitcnt vmcnt(0)" ::: "memory");
        } else {
            XB_SPIN(xb_ld(&bar[XB_XGEN(b.x)]) == gen, bar);
            __builtin_amdgcn_fence(__ATOMIC_ACQUIRE, "agent");
            asm volatile("s_waitcnt vmcnt(0)" ::: "memory");
        }
    }
    __syncthreads();
}

#ifndef MEGA
#define MEGA 1
#endif
#define REP_P0 1
#define REP_GEMM1 1
#define REP_P2 1
#define REP_P3 1
#define REP_UP 1
#define REP_A12 1
#define REP_C 1
#define REP_A3 1
#define REP_OUT 1
#define REP_SYNC 1
__global__ void __launch_bounds__(512, 2) mega_fwd(Params p) {
    extern __shared__ __attribute__((aligned(16))) unsigned char dlds[];
    cooperative_groups::grid_group grid = cooperative_groups::this_grid();
    LAS unsigned char* lds = (LAS unsigned char*)dlds;
    volatile LAS unsigned* bst = (volatile LAS unsigned*)(lds + LDS_BYTES - 64);
    if (threadIdx.x < 16) bst[threadIdx.x] = 0u;
    __syncthreads();
    (void)xcd_barrier_post((unsigned*)(p.ws + WS_CTL), bst);
    const bool bmap = (gridDim.x == 256);
    if (bmap && threadIdx.x == 0) __hip_atomic_store((unsigned*)(p.ws + WS_CTL) + 12288 + blockIdx.x, xb_xcc_id() + 1u, __ATOMIC_RELAXED, __HIP_MEMORY_SCOPE_AGENT);
    if (p.ws == nullptr) grid.sync();
#define GRID_SYNC() do { XcdBarrier b_; b_.bar = (unsigned*)(p.ws + WS_CTL); b_.x = xb_xcc_id(); b_.st = (volatile LAS unsigned*)((LAS unsigned char*)dlds + LDS_BYTES - 64); xcd_barrier(b_); } while (0)
#define GT_NG() const int tid_ = tid_opaque(), gt = blockIdx.x * 512 + tid_, ng = gridDim.x * 512, lane = tid_ & 63
#define LOCAL_SYNC() do { if (!*(volatile LAS unsigned*)((LAS unsigned char*)dlds + LDS_BYTES - 64 + 8)) { GRID_SYNC(); } else { \
        asm volatile("s_waitcnt vmcnt(0)" ::: "memory"); __syncthreads(); \
        if (threadIdx.x == 0) { unsigned* bar_ = (unsigned*)(p.ws + WS_CTL); const unsigned x_ = xb_xcc_id(), nloc_ = *(volatile LAS unsigned*)((LAS unsigned char*)dlds + LDS_BYTES - 64); \
            __builtin_amdgcn_s_waitcnt(0); \
            const unsigned old_ = xb_add(&bar_[XB_XSUB(x_)], 1u), gen_ = old_ / nloc_; \
            if (old_ + 1u == (gen_ + 1u) * nloc_) (void)xb_add(&bar_[XB_XGEN(x_)], 1u); else XB_SPIN(xb_ld(&bar_[XB_XGEN(x_)]) == gen_, bar_); \
            __builtin_amdgcn_fence(__ATOMIC_ACQUIRE, "agent"); asm volatile("s_waitcnt vmcnt(0)" ::: "memory"); } \
        __syncthreads(); } } while (0)
    for (int rep = 0; rep < REP_P0; ++rep) {
    GT_NG();
    prologue_weights<512>(p, (float*)dlds, blockIdx.x, gridDim.x);
    (void)gt; (void)ng;
    (void)lane; }
    for (int rep = 0; rep < REP_SYNC; ++rep) GRID_SYNC();
    {
      bool ok_ = bmap;
      if (bmap && threadIdx.x < 256) { const unsigned* arr_ = (const unsigned*)(p.ws + WS_CTL) + 12288; const unsigned v_ = xb_ld((unsigned*)&arr_[threadIdx.x]), h_ = xb_ld((unsigned*)&arr_[threadIdx.x % 8u]);
          ok_ = (v_ == h_) && (v_ != 0u);
          if (threadIdx.x < 8) { for (unsigned j = 0; j < 8; ++j) if (j != threadIdx.x && xb_ld((unsigned*)&arr_[j]) == v_) ok_ = false; } }
      volatile LAS unsigned* okw_ = (volatile LAS unsigned*)((LAS unsigned char*)dlds + LDS_BYTES - 64 + 12);
      if (threadIdx.x == 0) *okw_ = 1u; __syncthreads(); if (!ok_) *okw_ = 0u; __syncthreads(); const unsigned all_ = *okw_;
      if (threadIdx.x == 0) *(volatile LAS unsigned*)((LAS unsigned char*)dlds + LDS_BYTES - 64 + 8) = (all_ && *(volatile LAS unsigned*)((LAS unsigned char*)dlds + LDS_BYTES - 64) == gridDim.x / 8u) ? 1u : 0u;
      __syncthreads(); }
#define MEGA_LAYER(l) do { \
        for (int rep = 0; rep < REP_GEMM1; ++rep) ph_gemm1(p, l, lds); \
        for (int rep = 0; rep < REP_SYNC; ++rep) LOCAL_SYNC(); \
        for (int rep = 0; rep < REP_P2; ++rep) { \
          \
        const int xg_ = bmap ? (int)(blockIdx.x % 8) : 0, ox_ = xg_ % 6, ord2_ = ox_ == 0 ? 0x012 : ox_ == 1 ? 0x021 : ox_ == 2 ? 0x102 : ox_ == 3 ? 0x201 : ox_ == 4 ? 0x120 : 0x210;     \
        _Pragma("unroll 1") for (int st_ = 0; st_ < 3; ++st_) { const int w_ = (ord2_ >> (4 * st_)) & 15; \
            if (st_ == 1) { GT_NG(); (void)lane; if (bmap) kr_rope_pass(p, (int)(blockIdx.x % 8) * (T / 8) * 16 + (int)(blockIdx.x / 8) * 512 + tid_, (int)(gridDim.x / 8) * 512, ((int)(blockIdx.x % 8) + 1) * (T / 8) * 16); else kr_rope_pass(p, gt, ng, T * 16); }     \
            if (w_ == 0) { for (int r2 = 0; r2 < REP_UP; ++r2) ph_up(p, l, lds, bmap); } \
            else if (w_ == 1) att::band_run<att::BK_A_PART>(p, l, lds); \
            else att::band_run<att::BK_B>(p, l, lds); } } \
        for (int rep = 0; rep < REP_SYNC; ++rep) LOCAL_SYNC(); \
        for (int rep = 0; rep < REP_P3; ++rep) { \
        const bool merge_first_ = bmap && (((blockIdx.x % 8) & 2) != 0);     \
        _Pragma("unroll 1") for (int st_ = 0; st_ < 2; ++st_) { \
            if ((st_ == 0) == merge_first_) att::band_run<att::BK_A_MERGE>(p, l, lds); \
            else { const int G_ = gridDim.x, bx_ = blockIdx.x, vcu_ = (G_ % 8 == 0) ? (bx_ % 8) * (G_ / 8) + bx_ / 8 : bx_; \
                   att::attn_c_run(p, bmap ? 96 * (bx_ % 8) + bx_ / 8 : vcu_, bmap ? G_ / 8 : G_, bmap ? 96 * (bx_ % 8) + 96 : 768, lds); } } } \
        for (int rep = 0; rep < REP_SYNC; ++rep) LOCAL_SYNC(); \
        for (int rep = 0; rep < REP_OUT; ++rep) ph_out(p, l, lds); \
        for (int rep = 0; rep < REP_SYNC; ++rep) LOCAL_SYNC(); \
        GT_NG(); \
        const int rp_base = bmap ? (int)(blockIdx.x % 8) * (T / 8) : 0, rp_gw = bmap ? (int)(blockIdx.x / 8) * 8 + (tid_ >> 6) : (gt >> 6), rp_ngw = bmap ? (int)gridDim.x : (ng >> 6), rp_end = bmap ? ((int)(blockIdx.x % 8) + 1) * (T / 8) : T, rp_flip = bmap ? (2 * (int)(blockIdx.x % 8) + 1) * (T / 8) - 1 : -1;     \
        static_assert(DEPTH == 2, "the residual stream is carried from layer 0 to layer 1 as xb * rinv"); \
        if (l == 0) row_pass_pf<1>((const bf16_t*)(p.ws + WS_XB), (const bf16_t*)(p.ws + WS_Y), p.post_norm, nullptr, (bf16_t*)(p.ws + WS_XB), (float*)(p.ws + WS_RINV), rp_base, rp_gw, rp_ngw, lane, rp_end, rp_flip); \
        else row_pass_pf<2>((const bf16_t*)(p.ws + WS_XB), (const bf16_t*)(p.ws + WS_Y), p.post_norm + l * DM, p.out, nullptr, (float*)(p.ws + WS_RINV), rp_base, rp_gw, rp_ngw, lane, rp_end, rp_flip); \
    } while (0)
    MEGA_LAYER(0);
    for (int rep = 0; rep < REP_SYNC; ++rep) LOCAL_SYNC();
    MEGA_LAYER(1);
    static_assert(DEPTH == 2, "two layers, each its own copy of the layer body");
#undef MEGA_LAYER
}

extern "C" void kernel_launch(void* const* d_in, const int* in_sizes, int n_in, void* d_out, int out_size, void* d_ws, size_t ws_size, hipStream_t stream) {
    if (n_in != 11 || in_sizes[0] != T * DM || out_size != T * DM || ws_size < WS_END) { fprintf(stderr, "kernel_launch: shape/ws mismatch (ws %zu, need %zu)\n", ws_size, (size_t)WS_END); return; }
    Params p{};
    p.x = (const float*)d_in[0]; p.pos = (const int*)d_in[1]; p.pre_norm = (const float*)d_in[2]; p.w_in = (const float*)d_in[3]; p.q_norm = (const float*)d_in[4];
    p.kv_norm = (const float*)d_in[5]; p.w_uq = (const float*)d_in[6]; p.w_ukv = (const float*)d_in[7]; p.sink = (const float*)d_in[8]; p.w_o = (const float*)d_in[9];
    p.post_norm = (const float*)d_in[10]; p.out = (float*)d_out; p.ws = (unsigned char*)d_ws;
    unsigned char* ws = p.ws; (void)ws;
#if MEGA
    static int grid_blocks = 0;
    if (grid_blocks == 0) {
        int dev = 0, cus = 0, per_cu = 0;
        if (hipGetDevice(&dev) != hipSuccess || hipDeviceGetAttribute(&cus, hipDeviceAttributeMultiprocessorCount, dev) != hipSuccess) { fprintf(stderr, "kernel_launch: device query failed\n"); grid_blocks = -1; return; }
        if (hipFuncSetAttribute((const void*)mega_fwd, hipFuncAttributeMaxDynamicSharedMemorySize, LDS_BYTES) != hipSuccess) { fprintf(stderr, "kernel_launch: hipFuncSetAttribute failed\n"); grid_blocks = -1; return; }
        if (hipOccupancyMaxActiveBlocksPerMultiprocessor(&per_cu, (const void*)mega_fwd, 512, LDS_BYTES) != hipSuccess || per_cu < 1) { fprintf(stderr, "kernel_launch: occupancy query says %d blocks per CU\n", per_cu); (void)hipGetLastError(); per_cu = 1; }
        grid_blocks = cus * 1;
        fprintf(stderr, "kernel_launch: %d CUs, occupancy query %d per CU, grid %d\n", cus, per_cu, grid_blocks);
    }
    if (grid_blocks < 0) return;
    if (hipMemsetAsync((char*)d_ws + WS_CTL, 0, 65536, stream) != hipSuccess) { fprintf(stderr, "kernel_launch: memset failed\n"); return; }
    void* args[] = {(void*)&p};
    const hipError_t e = hipLaunchCooperativeKernel((const void*)mega_fwd, dim3(grid_blocks), dim3(512), args, LDS_BYTES, stream);
    if (e != hipSuccess) fprintf(stderr, "kernel_launch: cooperative launch failed: %s (grid %d)\n", hipGetErrorString(e), grid_blocks);
#endif
}
```
